# Optimizing an MI355X kernel written in HIP

```python
import math
import jax, jax.numpy as jnp
from jax import lax
import numpy as np

D_MODEL = 1024
BATCH = 16
SEQ = 4096
DEPTH = 1
DEC_BATCH = 16
DEC_SEQ = 64
PAST_LEN = 4096

CHUNK = 64
EPS = 1e-6
NEG_INF = -1e30

RET_HEADS = 4
RET_DK = 256
RET_DV = D_MODEL // RET_HEADS
ROPE_BASE = 10000.0

SWA_HEADS = 16
SWA_KV_HEADS = 2
SWA_GROUP = SWA_HEADS // SWA_KV_HEADS
SWA_HD = 64
WINDOW = 128
WIN_CHUNKS = WINDOW // CHUNK

REL_BUCKETS = 32
REL_MAX_DIST = 128

N_MEM = 256
MEM_HEADS = 4
MEM_HD = D_MODEL // MEM_HEADS

D_FF = -(-(8 * D_MODEL) // (3 * 256)) * 256

SPLIT_SIZES = (RET_HEADS * RET_DK, RET_HEADS * RET_DK, RET_HEADS * RET_DV, RET_HEADS * RET_DV,
               SWA_HEADS * SWA_HD, SWA_KV_HEADS * SWA_HD, SWA_KV_HEADS * SWA_HD, D_MODEL, D_MODEL)
SPLIT_OFFS = tuple(int(o) for o in np.cumsum(SPLIT_SIZES)[:-1])
D_IN = sum(SPLIT_SIZES)

kernel_name = 'hybrid_retention_swa_stream_step'


def rms_norm(x, g=None):
    xf = x.astype(jnp.float32)
    y = xf * lax.rsqrt(jnp.mean(xf * xf, axis=-1, keepdims=True) + EPS)
    if g is not None:
        y = y * g.astype(jnp.float32)
    return y.astype(x.dtype)


def rope(x, pos):
    half = x.shape[-1] // 2
    inv = ROPE_BASE ** (-jnp.arange(half, dtype=jnp.float32) / half)
    ang = pos.astype(jnp.float32)[:, None] * inv[None, :]
    cos = jnp.cos(ang)[:, None, :]
    sin = jnp.sin(ang)[:, None, :]
    xf = x.astype(jnp.float32)
    x1, x2 = xf[..., :half], xf[..., half:]
    return jnp.concatenate([x1 * cos - x2 * sin, x2 * cos + x1 * sin], axis=-1).astype(x.dtype)


def retention_log_decay():
    return jnp.log(1.0 - 2.0 ** (-5.0 - jnp.arange(RET_HEADS, dtype=jnp.float32)))


def retention_block(state, q, k, v, log_gamma):
    C = q.shape[1]
    idx = jnp.arange(C, dtype=jnp.float32)
    lg = log_gamma[None, :]
    intra = jnp.exp(log_gamma[:, None, None] * jnp.abs(idx[:, None] - idx[None, :]))
    s = jnp.einsum('bihd,bjhd->bhij', q, k, preferred_element_type=jnp.float32) * intra
    o = jnp.einsum('bhij,bjhe->bihe', s, v.astype(jnp.float32))
    q_dec = jnp.exp(lg * (idx[:, None] + 1.0))
    o = o + jnp.einsum('bihd,bhde->bihe', q.astype(jnp.float32), state) * q_dec[None, :, :, None]
    k_dec = jnp.exp(lg * (C - 1.0 - idx[:, None]))
    kv = jnp.einsum('bjhd,bjhe->bhde', k.astype(jnp.float32) * k_dec[None, :, :, None],
                    v.astype(jnp.float32))
    new_state = state * jnp.exp(log_gamma * C)[None, :, None, None] + kv
    return new_state, o


def retention_qkv(rq, rk, rv, pos):
    B, S = rq.shape[:2]
    q = rope(rq.reshape(B, S, RET_HEADS, RET_DK), pos)
    k = rope(rk.reshape(B, S, RET_HEADS, RET_DK), pos) * (RET_DK ** -0.5)
    v = rv.reshape(B, S, RET_HEADS, RET_DV)
    return q, k, v


def rel_bias_block(table, n_q, n_past):
    i = jnp.arange(n_q, dtype=jnp.int32)[:, None]
    j = jnp.arange(n_past + n_q, dtype=jnp.int32)[None, :]
    rel = (j - n_past) - i
    half = REL_BUCKETS // 2
    max_exact = half // 2
    n = jnp.abs(rel)
    large = max_exact + (jnp.log(jnp.maximum(n, 1).astype(jnp.float32) / max_exact)
                         / math.log(REL_MAX_DIST / max_exact) * (half - max_exact)).astype(jnp.int32)
    large = jnp.minimum(large, half - 1)
    bucket = jnp.where(rel > 0, half, 0) + jnp.where(n < max_exact, n, large)
    b = table[bucket]
    return jnp.transpose(b, (2, 0, 1)).reshape(SWA_KV_HEADS, SWA_GROUP, n_q, n_past + n_q)


def band_blocks(t):
    B, S = t.shape[:2]
    NC = S // CHUNK
    tp = jnp.pad(t, ((0, 0), (WINDOW, 0), (0, 0), (0, 0))).reshape(B, NC + WIN_CHUNKS, CHUNK, *t.shape[2:])
    return jnp.concatenate([tp[:, w:w + NC] for w in range(WIN_CHUNKS + 1)], axis=2)


def swa_attend(q, k, v, bias, sinks, valid):
    s = jnp.einsum('bnqhgd,bnkhd->bnhgqk', q, k, preferred_element_type=jnp.float32) * (SWA_HD ** -0.5)
    s = s + bias.astype(jnp.float32)
    if valid is not None:
        s = jnp.where(valid, s, NEG_INF)
    sink = sinks.astype(jnp.float32)[:, :, None, None]
    m = jnp.maximum(jnp.max(s, axis=-1, keepdims=True), sink)
    e = jnp.exp(s - m)
    p = e / (jnp.sum(e, axis=-1, keepdims=True) + jnp.exp(sink - m))
    return jnp.einsum('bnhgqk,bnkhd->bnqhgd', p.astype(v.dtype), v)


def in_proj(x, g_attn, w_in):
    return jnp.split(rms_norm(x, g_attn) @ w_in, SPLIT_OFFS, axis=-1)


def merge_branches(ret_o, ret_g, swa_o, gate_a, gate_b, w_ret_out, w_swa_out, w_mix_out):
    B, S = ret_g.shape[:2]
    a = (rms_norm(ret_o).astype(ret_g.dtype).reshape(B, S, -1) * jax.nn.silu(ret_g)) @ w_ret_out
    b = swa_o.reshape(B, S, -1) @ w_swa_out
    return (jax.nn.sigmoid(gate_a) * a + jax.nn.sigmoid(gate_b) * b) @ w_mix_out


def mixer_prompt(h, g_attn, w_in, w_ret_out, w_swa_out, w_mix_out, sinks, bias, log_gamma):
    B, S, _ = h.shape
    NC = S // CHUNK
    rq, rk, rv, rg, sq, sk, sv, ga, gb = in_proj(h, g_attn, w_in)
    pos = jnp.arange(S, dtype=jnp.int32)
    q, k, v = retention_qkv(rq, rk, rv, pos)
    blk = lambda t: jnp.swapaxes(t.reshape(B, NC, CHUNK, *t.shape[2:]), 0, 1)
    s0 = jnp.zeros((B, RET_HEADS, RET_DK, RET_DV), jnp.float32)
    ret_state, o = lax.scan(lambda st, xs: retention_block(st, xs[0], xs[1], xs[2], log_gamma),
                            s0, (blk(q), blk(k), blk(v)))
    ret_o = jnp.swapaxes(o, 0, 1).reshape(B, S, RET_HEADS, RET_DV)
    q_s = sq.reshape(B, NC, CHUNK, SWA_KV_HEADS, SWA_GROUP, SWA_HD)
    k_s = sk.reshape(B, S, SWA_KV_HEADS, SWA_HD)
    v_s = sv.reshape(B, S, SWA_KV_HEADS, SWA_HD)
    key_pos = (jnp.arange(NC, dtype=jnp.int32)[:, None] * CHUNK
               + jnp.arange(WINDOW + CHUNK, dtype=jnp.int32)[None, :] - WINDOW)
    valid = (key_pos >= 0)[None, :, None, None, None, :]
    swa_o = swa_attend(q_s, band_blocks(k_s), band_blocks(v_s), bias,
                       sinks.reshape(SWA_KV_HEADS, SWA_GROUP), valid)
    y = merge_branches(ret_o, rg, swa_o, ga, gb, w_ret_out, w_swa_out, w_mix_out)
    return y, ret_state, k_s[:, S - WINDOW:], v_s[:, S - WINDOW:]


def mixer_sample(h, ret_state, ck, cv, g_attn, w_in, w_ret_out, w_swa_out, w_mix_out, sinks, bias, log_gamma):
    B, T, _ = h.shape
    rq, rk, rv, rg, sq, sk, sv, ga, gb = in_proj(h, g_attn, w_in)
    pos = PAST_LEN + jnp.arange(T, dtype=jnp.int32)
    q, k, v = retention_qkv(rq, rk, rv, pos)
    new_state, ret_o = retention_block(ret_state.astype(jnp.float32), q, k, v, log_gamma)
    q_s = sq.reshape(B, 1, T, SWA_KV_HEADS, SWA_GROUP, SWA_HD)
    k_all = jnp.concatenate([ck, sk.reshape(B, T, SWA_KV_HEADS, SWA_HD).astype(ck.dtype)], axis=1)
    v_all = jnp.concatenate([cv, sv.reshape(B, T, SWA_KV_HEADS, SWA_HD).astype(cv.dtype)], axis=1)
    swa_o = swa_attend(q_s, k_all[:, None], v_all[:, None], bias,
                       sinks.reshape(SWA_KV_HEADS, SWA_GROUP), None)
    y = merge_branches(ret_o, rg, swa_o, ga, gb, w_ret_out, w_swa_out, w_mix_out)
    return y, new_state, k_all[:, T:], v_all[:, T:]


def mem_kv(mem, g_mem, w_mk, w_mv):
    B = mem.shape[0]
    mn = rms_norm(mem, g_mem)
    return ((mn @ w_mk).reshape(B, N_MEM, MEM_HEADS, MEM_HD),
            (mn @ w_mv).reshape(B, N_MEM, MEM_HEADS, MEM_HD))


def cross_attn(x, mk, mv, g_cross, w_cq, w_co):
    B, S, _ = x.shape
    q = (rms_norm(x, g_cross) @ w_cq).reshape(B, S, MEM_HEADS, MEM_HD)
    s = jnp.einsum('bqhd,bkhd->bhqk', q, mk, preferred_element_type=jnp.float32) * (MEM_HD ** -0.5)
    p = jax.nn.softmax(s, axis=-1).astype(mv.dtype)
    o = jnp.einsum('bhqk,bkhd->bqhd', p, mv).reshape(B, S, MEM_HEADS * MEM_HD)
    return o @ w_co


def swiglu(x, g_ffn, w_gate, w_up, w_down):
    hn = rms_norm(x, g_ffn)
    return (jax.nn.silu(hn @ w_gate) * (hn @ w_up)) @ w_down


def setup_inputs(seed: int = 0) -> dict:
    key = jax.random.key(seed)
    ks = jax.random.split(key, 26)

    def nrm(i, shape, scale=1.0):
        return jax.random.normal(ks[i], shape, jnp.float32) * scale

    def gain(i, shape):
        return 1.0 + 0.01 * jax.random.normal(ks[i], shape, jnp.float32)

    n_swa = min(WINDOW, PAST_LEN)
    L = DEPTH
    return {
        'x_prompt': nrm(0, (BATCH, SEQ, D_MODEL)),
        'x_sample': nrm(1, (DEC_BATCH, DEC_SEQ, D_MODEL)),
        'cache_ret_state': nrm(2, (L, DEC_BATCH, RET_HEADS, RET_DK, RET_DV), 0.1),
        'cache_swa_k': nrm(3, (L, DEC_BATCH, n_swa, SWA_KV_HEADS, SWA_HD)),
        'cache_swa_v': nrm(4, (L, DEC_BATCH, n_swa, SWA_KV_HEADS, SWA_HD)),
        'cache_mem_k': nrm(5, (L, DEC_BATCH, N_MEM, MEM_HEADS, MEM_HD)),
        'cache_mem_v': nrm(6, (L, DEC_BATCH, N_MEM, MEM_HEADS, MEM_HD)),
        'mem_prompt': nrm(7, (BATCH, N_MEM, D_MODEL)),
        'rel_bias': nrm(8, (REL_BUCKETS, SWA_HEADS), 0.1),
        'g_attn': gain(9, (L, D_MODEL)),
        'w_in': nrm(10, (L, D_MODEL, D_IN), D_MODEL ** -0.5),
        'w_ret_out': nrm(11, (L, RET_HEADS * RET_DV, D_MODEL), (RET_HEADS * RET_DV) ** -0.5),
        'w_swa_out': nrm(12, (L, SWA_HEADS * SWA_HD, D_MODEL), (SWA_HEADS * SWA_HD) ** -0.5),
        'w_mix_out': nrm(13, (L, D_MODEL, D_MODEL), D_MODEL ** -0.5),
        'swa_sinks': nrm(14, (L, SWA_HEADS)),
        'g_cross': gain(15, (L, D_MODEL)),
        'g_mem': gain(16, (L, D_MODEL)),
        'w_cq': nrm(17, (L, D_MODEL, MEM_HEADS * MEM_HD), D_MODEL ** -0.5),
        'w_mk': nrm(18, (L, D_MODEL, MEM_HEADS * MEM_HD), D_MODEL ** -0.5),
        'w_mv': nrm(19, (L, D_MODEL, MEM_HEADS * MEM_HD), D_MODEL ** -0.5),
        'w_co': nrm(20, (L, MEM_HEADS * MEM_HD, D_MODEL), (MEM_HEADS * MEM_HD) ** -0.5),
        'g_ffn': gain(21, (L, D_MODEL)),
        'w_gate': nrm(22, (L, D_MODEL, D_FF), D_MODEL ** -0.5),
        'w_up': nrm(23, (L, D_MODEL, D_FF), D_MODEL ** -0.5),
        'w_down': nrm(24, (L, D_FF, D_MODEL), D_FF ** -0.5),
        'g_final': gain(25, (D_MODEL,)),
    }


def reference(x_prompt, x_sample, cache_ret_state, cache_swa_k, cache_swa_v, cache_mem_k, cache_mem_v,
              mem_prompt, rel_bias, g_attn, w_in, w_ret_out, w_swa_out, w_mix_out, swa_sinks,
              g_cross, g_mem, w_cq, w_mk, w_mv, w_co, g_ffn, w_gate, w_up, w_down, g_final):
    log_gamma = retention_log_decay()
    T = x_sample.shape[1]
    bias_p = rel_bias_block(rel_bias, CHUNK, WINDOW)
    bias_s = rel_bias_block(rel_bias, T, cache_swa_k.shape[2])
    hp, hs = x_prompt, x_sample
    ret_p, ret_s, kp, ksm, vp, vsm, mkp, mvp = [], [], [], [], [], [], [], []
    for l in range(DEPTH):
        y, st, kb, vb = mixer_prompt(hp, g_attn[l], w_in[l], w_ret_out[l], w_swa_out[l], w_mix_out[l],
                                     swa_sinks[l], bias_p, log_gamma)
        hp = hp + y
        mk, mv = mem_kv(mem_prompt, g_mem[l], w_mk[l], w_mv[l])
        hp = hp + cross_attn(hp, mk, mv, g_cross[l], w_cq[l], w_co[l])
        hp = hp + swiglu(hp, g_ffn[l], w_gate[l], w_up[l], w_down[l])
        ret_p.append(st); kp.append(kb); vp.append(vb); mkp.append(mk); mvp.append(mv)
        y, st, kb, vb = mixer_sample(hs, cache_ret_state[l], cache_swa_k[l], cache_swa_v[l], g_attn[l], w_in[l],
                                     w_ret_out[l], w_swa_out[l], w_mix_out[l], swa_sinks[l], bias_s, log_gamma)
        hs = hs + y
        hs = hs + cross_attn(hs, cache_mem_k[l], cache_mem_v[l], g_cross[l], w_cq[l], w_co[l])
        hs = hs + swiglu(hs, g_ffn[l], w_gate[l], w_up[l], w_down[l])
        ret_s.append(st); ksm.append(kb); vsm.append(vb)
    y_prompt = rms_norm(hp, g_final)
    y_sample = rms_norm(hs, g_final)
    return (y_prompt, y_sample, jnp.stack(ret_p), jnp.stack(ret_s), jnp.stack(kp), jnp.stack(ksm),
            jnp.stack(vp), jnp.stack(vsm), jnp.stack(mkp), jnp.stack(mvp))
```

```cpp
#include <hip/hip_runtime.h>
#include <hip/hip_cooperative_groups.h>
#include <cstdio>
#include <cstdint>
namespace cg = cooperative_groups;

#define LAS __attribute__((address_space(3)))
#define DI __device__ __forceinline__
typedef unsigned short bf16_t;
typedef short bf16x8 __attribute__((ext_vector_type(8)));
typedef short s16x4 __attribute__((ext_vector_type(4)));
typedef float f32x4 __attribute__((ext_vector_type(4)));
typedef unsigned u32x4 __attribute__((ext_vector_type(4)));
typedef unsigned u32x2 __attribute__((ext_vector_type(2)));
typedef LAS unsigned char* lptr;
typedef _Float16 h16x2 __attribute__((ext_vector_type(2)));

constexpr int DM = 1024, SEQ = 4096, NB = 16, MP = NB * SEQ, MS = 1024, MT = MP + MS;
constexpr int DIN = 7424, DFF = 2816, NMEM = 256;
constexpr int C_RQ = 0, C_RK = 1024, C_RV = 2048, C_RG = 3072, C_SQ = 4096, C_SK = 5120, C_SV = 5248, C_GA = 5376, C_GB = 6400;
constexpr size_t GSZ = (size_t)MT * 1024, G_RQ = 0, G_RK = GSZ, G_RV = 2 * GSZ, G_RG = 3 * GSZ, G_SQ = 4 * GSZ, G_SKV = 5 * GSZ  , G_GA = G_SKV + (size_t)MT * 256, G_GB = G_GA + GSZ;
static_assert(G_GB + GSZ == (size_t)MT * DIN, "P groups");
constexpr float EPS = 1e-6f, LOG2E = 1.4426950408889634f;
constexpr size_t O_Y = 0, O_RSP = (size_t)MT * DM, O_RSS = O_RSP + 4194304, O_KP = O_RSS + 4194304, O_KS = O_KP + 262144, O_VP = O_KS + 262144,
                 O_VS = O_VP + 262144, O_MK = O_VS + 262144, O_MV = O_MK + 4194304;
constexpr size_t OB_XB = 0, OB_MB = (size_t)140 << 20;
constexpr size_t O_ROPE = O_RSP, O_RSTD1 = O_RSS, O_RSTDM = O_RSS + MT;
constexpr size_t WS_SSQR = 0, WS_SSQ2 = (size_t)MT * 16, WS_SSQ3 = WS_SSQ2 + (size_t)MT * 4, WS_SSQ4 = WS_SSQ3 + (size_t)MT * 4, WS_ZEND = WS_SSQ4 + (size_t)MT * 4;
constexpr size_t WS_WIN = (size_t)2 << 20, WS_WRO = WS_WIN + (size_t)DIN * DM * 2, WS_WSO = WS_WRO + 2097152, WS_WMX = WS_WSO + 2097152, WS_WCQ = WS_WMX + 2097152,
                 WS_WCO = WS_WCQ + 2097152, WS_WMKV = WS_WCO + 2097152, WS_WGU = WS_WMKV + 4194304, WS_WDN = WS_WGU + (size_t)2 * DFF * DM * 2, WS_WEND = WS_WDN + (size_t)DM * DFF * 2;
constexpr size_t WS_P = (size_t)48 << 20, WS_END = WS_P + (size_t)MT * DIN * 2;
static_assert(WS_ZEND <= WS_WIN && WS_WEND <= WS_P && WS_END <= ((size_t)1 << 30), "ws map");
constexpr size_t WS_XBUF = (WS_END + 255) / 256 * 256, WS_XCNT = WS_XBUF + (size_t)MP * 16, WS_END2 = WS_XCNT + 256 * 256;
constexpr size_t WS_MKVB = WS_END2, WS_CKVB = WS_MKVB + (size_t)NB * NMEM * 2048 * 2, WS_END3 = WS_CKVB + (size_t)NB * NMEM * 2048 * 2;
static_assert(WS_END3 <= ((size_t)1 << 30), "ws map 2");
constexpr int LDS_BYTES = 147456;

typedef float f32x2_t __attribute__((ext_vector_type(2)));
typedef __bf16 bf16x2_t __attribute__((ext_vector_type(2)));
DI unsigned cvt_pk_bf16(float lo, float hi) { const f32x2_t v = {lo, hi}; const bf16x2_t b = __builtin_convertvector(v, bf16x2_t); return __builtin_bit_cast(unsigned, b); }
DI float bf_lo(unsigned w) { return __uint_as_float(w << 16); }
DI float bf_hi(unsigned w) { return __uint_as_float(w & 0xffff0000u); }
DI void st8(bf16_t* p, f32x4 a, f32x4 b) { u32x4 w; w.x = cvt_pk_bf16(a.x, a.y); w.y = cvt_pk_bf16(a.z, a.w); w.z = cvt_pk_bf16(b.x, b.y); w.w = cvt_pk_bf16(b.z, b.w); *(u32x4*)p = w; }
DI void ld8(const bf16_t* p, f32x4& a, f32x4& b) { const u32x4 w = *(const u32x4*)p; a.x = bf_lo(w.x); a.y = bf_hi(w.x); a.z = bf_lo(w.y); a.w = bf_hi(w.y); b.x = bf_lo(w.z); b.y = bf_hi(w.z); b.z = bf_lo(w.w); b.w = bf_hi(w.w); }
DI float sigm(float x) { return __builtin_amdgcn_rcpf(1.f + __builtin_amdgcn_exp2f(-x * LOG2E)); }
DI f32x4 sigm4(f32x4 v) { f32x4 r; r.x = sigm(v.x); r.y = sigm(v.y); r.z = sigm(v.z); r.w = sigm(v.w); return r; }
DI float dot4(f32x4 a) { return (a.x * a.x + a.y * a.y) + (a.z * a.z + a.w * a.w); }
DI float wave_sum(float v) {
#pragma unroll
    for (int o = 1; o < 64; o <<= 1) v += __shfl_xor(v, o);
    return v;
}

namespace pg8 {
constexpr int BM = 256, BK = 64, HALF = 128, HTB = HALF * BK * 2, STAGE_BYTES = 8 * HTB, NXCD = 8, WGM = 8;
DI int lds_byte(int r, int c) { const int st = (r >> 4) * 2 + (c >> 5), rr = r & 15, cc = c & 31, ob = rr * 64 + cc * 2; return st * 1024 + (ob ^ (((ob >> 9) & 1) << 5)); }
DI void stage_rc(int b, int& R, int& C) { const int st = b / 1024, sb = b % 1024, swz = sb ^ (((sb >> 9) & 1) << 5); R = (st >> 1) * 16 + swz / 64; C = (st & 1) * 32 + (swz % 64) / 2; }
DI int perm32(int rho) { const int n = rho >> 4, i = rho & 15; return 8 * (i >> 2) + 4 * n + (i & 3); }
struct Unit { int pm, pn, r0, ui; };
struct Gemm { const bf16_t* A; int lda; const bf16_t* Bt; int M, N, K; };
struct StaticOrder {
    int nM, nN, nwg, G, c;
    DI void init(int M, int N, int G_, int c_) { nM = M / BM; nN = N / BM; nwg = nM * nN; G = G_; c = c_; }
    DI bool next(int i, Unit& u) const {
        const long L = (long)i * G + c; if (L >= nwg) return false;
        int wgid = (int)L; { const int q = nwg / NXCD, r = nwg % NXCD, xcd = wgid % NXCD, off = wgid / NXCD; wgid = (xcd < r ? xcd * (q + 1) : r * (q + 1) + (xcd - r) * q) + off; }
        const int nig = WGM * nN, gid = wgid / nig, fm = gid * WGM, gsz = (nM - fm) < WGM ? (nM - fm) : WGM;
        u.pm = fm + ((wgid % nig) % gsz); u.pn = (wgid % nig) / gsz; u.r0 = u.pm * BM; u.ui = i; return true;
    }
};
template <class Epi, bool ALIGN_EPI>
DI void gemm_phase(lptr lds, const Gemm g, const StaticOrder& S, const Epi& E) {
    const int tid = threadIdx.x, wid = __builtin_amdgcn_readfirstlane(tid >> 6), lane = tid & 63, wr = wid >> 2, wc = wid & 3, fr = lane & 15, fq = lane >> 4;
    const int K = g.K, nt = K / BK, lda = g.lda;
    unsigned voffA[2], voffB[2];
#pragma unroll
    for (int i = 0; i < 2; ++i) { int R, C; stage_rc(tid * 16 + i * 8192, R, C); const int Rb = (R & ~31) + perm32(R & 31);
        voffA[i] = (unsigned)(R * lda + C) * 2u; voffB[i] = (unsigned)(Rb * K + C) * 2u; }
    const size_t kstep = (size_t)(BK * 2);
    const size_t hstepA = (size_t)HALF * lda * 2, hstepB = (size_t)HALF * K * 2, tstepA = 2 * hstepA, tstepB = 2 * hstepB;
    const unsigned ldsw = (unsigned)wid * 1024u;
    const int aoff = lds_byte(wr * 64 + fr, fq * 8), boff = lds_byte(wc * 32 + fr, fq * 8);
#define PG8_SA(b, h) (((b) * 2 + (h)) * HTB)
#define PG8_SB(b, h) ((4 + (b) * 2 + (h)) * HTB)
#define PG8_STAGE(bufoff, gbase, voff) do { _Pragma("unroll") for (int _i = 0; _i < 2; ++_i) \
        __builtin_amdgcn_global_load_lds((const unsigned*)((const char*)(gbase) + (voff)[_i]), (LAS unsigned*)(lds + (bufoff) + ldsw + _i * 8192), 16, 0, 0); } while (0)
#define PG8_LDA(dst, b, h) do { _Pragma("unroll") for (int m = 0; m < 4; ++m) _Pragma("unroll") for (int k = 0; k < 2; ++k) dst[m][k] = *(const LAS bf16x8*)(lds + PG8_SA(b, h) + aoff + m * 2048 + k * 1024); } while (0)
#define PG8_LDB(dst, b, h) do { _Pragma("unroll") for (int n = 0; n < 2; ++n) _Pragma("unroll") for (int k = 0; k < 2; ++k) dst[n][k] = *(const LAS bf16x8*)(lds + PG8_SB(b, h) + boff + n * 2048 + k * 1024); } while (0)
#define PG8_MMA(ai, bj, At, Bt) do { __builtin_amdgcn_s_setprio(1); _Pragma("unroll") for (int m = 0; m < 4; ++m) _Pragma("unroll") for (int n = 0; n < 2; ++n) _Pragma("unroll") for (int k = 0; k < 2; ++k) \
        acc[ai][bj][m][n] = __builtin_amdgcn_mfma_f32_16x16x32_bf16(Bt[n][k], At[m][k], acc[ai][bj][m][n], 0, 0, 0); __builtin_amdgcn_s_setprio(0); } while (0)
#define PG8_WAIT_V(n) asm volatile("s_waitcnt vmcnt(" #n ")" ::: "memory")
#define PG8_WAIT_L(n) asm volatile("s_waitcnt lgkmcnt(" #n ")" ::: "memory")
#define PG8_BAR __builtin_amdgcn_s_barrier()
#define PG8_SCHED __builtin_amdgcn_sched_barrier(0)
    Unit cur, nxt; int ui = 0;
    if (!S.next(0, cur)) return;
    f32x4 acc[2][2][4][2];
#pragma unroll
    for (int a = 0; a < 2; ++a)
#pragma unroll
        for (int b = 0; b < 2; ++b)
#pragma unroll
            for (int m = 0; m < 4; ++m)
#pragma unroll
                for (int n = 0; n < 2; ++n) acc[a][b][m][n] = (f32x4){0.f, 0.f, 0.f, 0.f};
    bf16x8 At[4][2], B0[2][2], B1[2][2];
    const char* cA = (const char*)g.A + (size_t)cur.pm * tstepA; const char* cB = (const char*)g.Bt + (size_t)cur.pn * tstepB;
    if constexpr (Epi::RESCALE) E.prep(cur, tid);
    PG8_STAGE(PG8_SB(0, 0), cB, voffB); PG8_STAGE(PG8_SB(0, 1), cB + hstepB, voffB); PG8_STAGE(PG8_SA(0, 0), cA, voffA); PG8_STAGE(PG8_SA(0, 1), cA + hstepA, voffA);
    if (wr == 1) PG8_BAR;
    PG8_WAIT_V(2); PG8_BAR;
    PG8_STAGE(PG8_SB(1, 0), cB + kstep, voffB); PG8_STAGE(PG8_SA(1, 0), cA + kstep, voffA); PG8_STAGE(PG8_SB(1, 1), cB + hstepB + kstep, voffB);
    PG8_WAIT_V(6); PG8_BAR;
    for (;;) {
        const bool has_next = S.next(ui + 1, nxt);
        const char* nA = has_next ? (const char*)g.A + (size_t)nxt.pm * tstepA : cA; const char* nB = has_next ? (const char*)g.Bt + (size_t)nxt.pn * tstepB : cB;
        for (int t = 0; t < nt; t += 2) {
            const bool last = (t == nt - 2);
            if constexpr (Epi::RESCALE) { if (t == 4 || t == 8 || t == 12) E.rescale(acc, cur, t >> 2, wr, fr); }
            const char* a1 = cA + (size_t)(t + 1) * kstep;
            const char* a2 = last ? nA : cA + (size_t)(t + 2) * kstep; const char* b2 = last ? nB : cB + (size_t)(t + 2) * kstep;
            const char* a3 = a2 + kstep; const char* b3 = b2 + kstep;
            PG8_LDB(B0, 0, 0); PG8_LDB(B1, 0, 1); PG8_SCHED; PG8_LDA(At, 0, 0); PG8_STAGE(PG8_SA(1, 1), a1 + hstepA, voffA);
            PG8_WAIT_V(8); PG8_WAIT_L(0); PG8_BAR; PG8_MMA(0, 0, At, B0); PG8_MMA(0, 1, At, B1); PG8_BAR; PG8_SCHED;
            PG8_LDA(At, 0, 1); PG8_STAGE(PG8_SB(0, 0), b2, voffB); PG8_STAGE(PG8_SB(0, 1), b2 + hstepB, voffB); PG8_STAGE(PG8_SA(0, 0), a2, voffA);
            PG8_WAIT_V(8); PG8_WAIT_L(0); PG8_BAR; PG8_MMA(1, 0, At, B0); PG8_MMA(1, 1, At, B1); PG8_BAR; PG8_SCHED;
            PG8_LDB(B0, 1, 0); PG8_LDB(B1, 1, 1); PG8_SCHED; PG8_LDA(At, 1, 0); PG8_STAGE(PG8_SA(0, 1), a2 + hstepA, voffA);
            PG8_WAIT_V(8); PG8_WAIT_L(0); PG8_BAR; PG8_MMA(0, 0, At, B0); PG8_MMA(0, 1, At, B1); PG8_BAR; PG8_SCHED;
            PG8_LDA(At, 1, 1); PG8_STAGE(PG8_SB(1, 0), b3, voffB); PG8_STAGE(PG8_SB(1, 1), b3 + hstepB, voffB); PG8_STAGE(PG8_SA(1, 0), a3, voffA);
            PG8_WAIT_V(8); PG8_WAIT_L(0); PG8_BAR; PG8_MMA(1, 0, At, B0); PG8_MMA(1, 1, At, B1); PG8_BAR; PG8_SCHED;
        }
        if constexpr (ALIGN_EPI) { if (wr == 0) PG8_BAR; }
        E.template run<2>(acc, cur, wr, wc, fr, fq);
        if (!has_next) break;
#pragma unroll
        for (int a = 0; a < 2; ++a)
#pragma unroll
            for (int b = 0; b < 2; ++b)
#pragma unroll
                for (int m = 0; m < 4; ++m)
#pragma unroll
                    for (int n = 0; n < 2; ++n) acc[a][b][m][n] = (f32x4){0.f, 0.f, 0.f, 0.f};
        cur = nxt; cA = nA; cB = nB; ++ui;
        if constexpr (Epi::RESCALE) E.prep(cur, tid);
        if constexpr (ALIGN_EPI) { if (wr == 1) PG8_BAR; }
    }
    PG8_WAIT_V(0);
    if constexpr (!ALIGN_EPI) { if (wr == 0) PG8_BAR; }
    PG8_BAR;
#undef PG8_SA
#undef PG8_SB
#undef PG8_STAGE
#undef PG8_LDA
#undef PG8_LDB
#undef PG8_MMA
#undef PG8_WAIT_V
#undef PG8_WAIT_L
#undef PG8_BAR
#undef PG8_SCHED
}
}
typedef short v4i16_t __attribute__((ext_vector_type(4)));
DI bf16x8 lds16(lptr p) { return *(const LAS bf16x8*)p; }
DI s16x4 ldstr(lptr p) { return __builtin_bit_cast(s16x4, __builtin_amdgcn_ds_read_tr16_b64_v4i16((LAS v4i16_t*)p)); }
DI bf16x8 tr_pair(lptr p0, lptr p1) { const s16x4 a = ldstr(p0), b = ldstr(p1); return (bf16x8){a.x, a.y, a.z, a.w, b.x, b.y, b.z, b.w}; }
DI bf16x8 pack8(f32x4 a, f32x4 b) { u32x4 w; w.x = cvt_pk_bf16(a.x, a.y); w.y = cvt_pk_bf16(a.z, a.w); w.z = cvt_pk_bf16(b.x, b.y); w.w = cvt_pk_bf16(b.z, b.w); return __builtin_bit_cast(bf16x8, w); }
DI u32x2 pack4(f32x4 a) { u32x2 w; w.x = cvt_pk_bf16(a.x, a.y); w.y = cvt_pk_bf16(a.z, a.w); return w; }
DI f32x4 mfma16(bf16x8 a, bf16x8 b, f32x4 c) { return __builtin_amdgcn_mfma_f32_16x16x32_bf16(a, b, c, 0, 0, 0); }
DI float ex2(float x) { return __builtin_amdgcn_exp2f(x); }
DI void lds_barrier() { asm volatile("s_waitcnt lgkmcnt(0)" ::: "memory"); __builtin_amdgcn_s_barrier(); asm volatile("" ::: "memory"); }

using pg8::Unit;
#define EPI_ROW(ai, m) (u.r0 + (ai) * 128 + wr * 64 + (m) * 16 + fr)
typedef const f32x4 (&AccRef)[2][2][4][2];

DI float f16lo(unsigned w) { return (float)__builtin_bit_cast(h16x2, w).x; }
DI float f16hi(unsigned w) { return (float)__builtin_bit_cast(h16x2, w).y; }
struct EpiInProj {
    static constexpr bool RESCALE = false;
    bf16_t* P; const float* rstd; const unsigned* rope;
    template <int NAI> DI void run(AccRef acc, const Unit& u, int wr, int wc, int fr, int fq) const {
        const int pn = u.pn, cl = wc * 32 + fq * 8;
        bf16_t* const gbase = pn < 20 ? P + (size_t)(pn >> 2) * GSZ + (pn & 3) * 256 : pn == 20 ? P + G_SKV : P + G_GA + (size_t)((pn - 21) >> 2) * GSZ + ((pn - 21) & 3) * 256;
        const unsigned pitch = pn == 20 ? 256u : 1024u;
        float rsv[2][4];
#pragma unroll
        for (int ai = 0; ai < NAI; ++ai)
#pragma unroll
            for (int m = 0; m < 4; ++m) rsv[ai][m] = rstd[EPI_ROW(ai, m)];
#pragma unroll
        for (int ai = 0; ai < NAI; ++ai) {
            if (pn < 8) {
                u32x4 cs[4][2];
#pragma unroll
                for (int m = 0; m < 4; ++m) { const int row = EPI_ROW(ai, m); const int pos = row < MP ? (row & (SEQ - 1)) : (SEQ + ((row - MP) & 63));
                    const unsigned* tp = rope + pos * 128 + cl; cs[m][0] = *(const u32x4*)tp; cs[m][1] = *(const u32x4*)(tp + 4); }
#pragma unroll
                for (int m = 0; m < 4; ++m) { const int row = EPI_ROW(ai, m); bf16_t* prow = gbase + ((unsigned)row * pitch + (unsigned)cl);
                    const float sc = pn >= 4 ? rsv[ai][m] * 0.0625f : rsv[ai][m];
                    const u32x4 w0 = cs[m][0], w1 = cs[m][1];
                    const f32x4 c0 = (f32x4){f16lo(w0.x), f16lo(w0.y), f16lo(w0.z), f16lo(w0.w)}, s0 = (f32x4){f16hi(w0.x), f16hi(w0.y), f16hi(w0.z), f16hi(w0.w)};
                    const f32x4 c1 = (f32x4){f16lo(w1.x), f16lo(w1.y), f16lo(w1.z), f16lo(w1.w)}, s1 = (f32x4){f16hi(w1.x), f16hi(w1.y), f16hi(w1.z), f16hi(w1.w)};
                    const f32x4 x10 = acc[ai][0][m][0] * sc, x11 = acc[ai][0][m][1] * sc, x20 = acc[ai][1][m][0] * sc, x21 = acc[ai][1][m][1] * sc;
                    st8(prow, x10 * c0 - x20 * s0, x11 * c1 - x21 * s1);
                    st8(prow + 128, x20 * c0 + x10 * s0, x21 * c1 + x11 * s1); }
            } else {
#pragma unroll
                for (int m = 0; m < 4; ++m) { const int row = EPI_ROW(ai, m); bf16_t* prow = gbase + ((unsigned)row * pitch + (unsigned)cl); const float rs = rsv[ai][m];
#pragma unroll
                    for (int bj = 0; bj < 2; ++bj) {
                        f32x4 a = acc[ai][bj][m][0] * rs, b = acc[ai][bj][m][1] * rs;
                        if (pn >= 12 && pn < 16) { a = a * sigm4(a); b = b * sigm4(b); }
                        else if (pn >= 16 && pn < 20) { a = a * 0.125f; b = b * 0.125f; }
                        else if (pn >= 21) { a = sigm4(a); b = sigm4(b); }
                        st8(prow + bj * 128, a, b);
                    } }
            }
        }
    }
};
struct EpiMemKV {
    static constexpr bool RESCALE = false;
    float* mk; float* mv; const float* rstd; bf16_t* kvb;
    template <int NAI> DI void run(AccRef acc, const Unit& u, int wr, int wc, int fr, int fq) const {
        const int pn = u.pn, cl = wc * 32 + fq * 8; float* base = pn < 4 ? mk : mv;
        float rsv[2][4];
#pragma unroll
        for (int ai = 0; ai < NAI; ++ai)
#pragma unroll
            for (int m = 0; m < 4; ++m) rsv[ai][m] = rstd[EPI_ROW(ai, m)];
#pragma unroll
        for (int ai = 0; ai < NAI; ++ai)
#pragma unroll
            for (int m = 0; m < 4; ++m) {
                const int row = EPI_ROW(ai, m); const float rs = rsv[ai][m];
#pragma unroll
                for (int bj = 0; bj < 2; ++bj) { float* d = base + (size_t)row * DM + (pn & 3) * 256 + bj * 128 + cl;
                    const f32x4 a = acc[ai][bj][m][0] * rs, b = acc[ai][bj][m][1] * rs;
                    __builtin_nontemporal_store(a, (f32x4*)d); __builtin_nontemporal_store(b, (f32x4*)(d + 4)); st8(kvb + (size_t)row * 2048 + pn * 256 + bj * 128 + cl, a, b); }
            }
    }
};
DI void unpack8(const u32x4 w, f32x4& a, f32x4& b) { a.x = bf_lo(w.x); a.y = bf_hi(w.x); a.z = bf_lo(w.y); a.w = bf_hi(w.y); b.x = bf_lo(w.z); b.y = bf_hi(w.z); b.z = bf_lo(w.w); b.w = bf_hi(w.w); }
struct EpiSwaOut {
    static constexpr bool RESCALE = false;
    bf16_t* P;
    template <int NAI> DI void run(AccRef acc, const Unit& u, int wr, int wc, int fr, int fq) const {
        const int cl = u.pn * 256 + wc * 32 + fq * 8;
#pragma unroll
        for (int ai = 0; ai < NAI; ++ai) {
            u32x4 gv[4][2];
#pragma unroll
            for (int m = 0; m < 4; ++m)
#pragma unroll
                for (int bj = 0; bj < 2; ++bj) gv[m][bj] = *(const u32x4*)(P + G_GB + (size_t)EPI_ROW(ai, m) * 1024 + cl + bj * 128);
#pragma unroll
            for (int m = 0; m < 4; ++m)
#pragma unroll
                for (int bj = 0; bj < 2; ++bj) { f32x4 ga, gb; unpack8(gv[m][bj], ga, gb);
                    st8(P + G_GB + (size_t)EPI_ROW(ai, m) * 1024 + cl + bj * 128, acc[ai][bj][m][0] * ga, acc[ai][bj][m][1] * gb); }
        }
    }
};
struct EpiRetOut {
    static constexpr bool RESCALE = true;
    bf16_t* P; const float* ssqr; lptr tbl;
    DI f32x4 factors(int row) const { const f32x4 q = *(const f32x4*)(ssqr + (size_t)row * 4);
        const float s0 = __builtin_amdgcn_rsqf(q.x * (1.f / 256.f) + EPS), s1 = __builtin_amdgcn_rsqf(q.y * (1.f / 256.f) + EPS), s2 = __builtin_amdgcn_rsqf(q.z * (1.f / 256.f) + EPS), s3 = __builtin_amdgcn_rsqf(q.w * (1.f / 256.f) + EPS);
        return (f32x4){s0 * __builtin_amdgcn_rcpf(s1), s1 * __builtin_amdgcn_rcpf(s2), s2 * __builtin_amdgcn_rcpf(s3), s3}; }
    DI void prep(const Unit& u, int tid) const { if (tid < 256) *(LAS f32x4*)(tbl + (u.ui & 1) * 4096 + tid * 16) = factors(u.r0 + tid); }
    DI void rescale(f32x4 (&acc)[2][2][4][2], const Unit& u, int h, int wr, int fr) const {
        const LAS float* T = (const LAS float*)(tbl + (u.ui & 1) * 4096);
#pragma unroll
        for (int ai = 0; ai < 2; ++ai)
#pragma unroll
            for (int m = 0; m < 4; ++m) { const float r = T[(ai * 128 + wr * 64 + m * 16 + fr) * 4 + (h - 1)];
#pragma unroll
                for (int bj = 0; bj < 2; ++bj)
#pragma unroll
                    for (int n = 0; n < 2; ++n) acc[ai][bj][m][n] = acc[ai][bj][m][n] * r; }
    }
    template <int NAI> DI void run(AccRef acc, const Unit& u, int wr, int wc, int fr, int fq) const {
        const int cl = u.pn * 256 + wc * 32 + fq * 8;
        const LAS float* T = (const LAS float*)(tbl + (u.ui & 1) * 4096);
        float s3v[2][4];
#pragma unroll
        for (int ai = 0; ai < NAI; ++ai)
#pragma unroll
            for (int m = 0; m < 4; ++m) s3v[ai][m] = NAI == 2 ? T[(ai * 128 + wr * 64 + m * 16 + fr) * 4 + 3] : factors(EPI_ROW(ai, m)).w;
#pragma unroll
        for (int ai = 0; ai < NAI; ++ai)
#pragma unroll
        for (int mh = 0; mh < 4; mh += 2) {
            u32x4 gv[4][2], mv[4][2];
#pragma unroll
            for (int m = mh; m < mh + 2; ++m)
#pragma unroll
                for (int bj = 0; bj < 2; ++bj) { const bf16_t* g = P + G_GA + (size_t)EPI_ROW(ai, m) * 1024 + cl + bj * 128; gv[m][bj] = *(const u32x4*)g; mv[m][bj] = *(const u32x4*)(g + (G_GB - G_GA)); }
#pragma unroll
            for (int m = mh; m < mh + 2; ++m)
#pragma unroll
                for (int bj = 0; bj < 2; ++bj) { f32x4 ga, gb, ma, mb; unpack8(gv[m][bj], ga, gb); unpack8(mv[m][bj], ma, mb); const float s3 = s3v[ai][m];
                    st8(P + G_GA + (size_t)EPI_ROW(ai, m) * 1024 + cl + bj * 128, acc[ai][bj][m][0] * s3 * ga + ma, acc[ai][bj][m][1] * s3 * gb + mb); }
        }
    }
};
template <bool FROM_X, bool WRITE_HB> struct EpiResid {
    static constexpr bool RESCALE = false;
    const float* xp; const float* xs; float* H; bf16_t* P; float* ssq;
    template <int NAI> DI void run(AccRef acc, const Unit& u, int wr, int wc, int fr, int fq) const {
        const int cl = u.pn * 256 + wc * 32 + fq * 8;
#pragma unroll
        for (int ai = 0; ai < NAI; ++ai)
#pragma unroll
        for (int mh = 0; mh < 4; mh += 2) {
            f32x4 xv[4][2][2];
#pragma unroll
            for (int m = mh; m < mh + 2; ++m) { const int row = EPI_ROW(ai, m);
                const float* src = FROM_X ? (row < MP ? xp + (size_t)row * DM : xs + (size_t)(row - MP) * DM) : H + (size_t)row * DM;
#pragma unroll
                for (int bj = 0; bj < 2; ++bj) { xv[m][bj][0] = *(const f32x4*)(src + cl + bj * 128); xv[m][bj][1] = *(const f32x4*)(src + cl + bj * 128 + 4); } }
#pragma unroll
            for (int m = mh; m < mh + 2; ++m) { const int row = EPI_ROW(ai, m); float ss = 0.f;
#pragma unroll
                for (int bj = 0; bj < 2; ++bj) { const int col = cl + bj * 128;
                    const f32x4 a = xv[m][bj][0] + acc[ai][bj][m][0], b = xv[m][bj][1] + acc[ai][bj][m][1];
                    __builtin_nontemporal_store(a, (f32x4*)(H + (size_t)row * DM + col)); __builtin_nontemporal_store(b, (f32x4*)(H + (size_t)row * DM + col + 4));
                    if (WRITE_HB) st8(P + G_RQ + (size_t)row * 1024 + col, a, b);
                    ss += dot4(a) + dot4(b); }
                ss += __shfl_xor(ss, 16); ss += __shfl_xor(ss, 32);
                if (fq == 0) unsafeAtomicAdd(ssq + row, ss); }
        }
    }
};
struct EpiCq {
    static constexpr bool RESCALE = false;
    bf16_t* P; const float* ssq;
    template <int NAI> DI void run(AccRef acc, const Unit& u, int wr, int wc, int fr, int fq) const {
        const int cl = u.pn * 256 + wc * 32 + fq * 8;
        float rsv[2][4];
#pragma unroll
        for (int ai = 0; ai < NAI; ++ai)
#pragma unroll
            for (int m = 0; m < 4; ++m) rsv[ai][m] = ssq[EPI_ROW(ai, m)];
#pragma unroll
        for (int ai = 0; ai < NAI; ++ai)
#pragma unroll
            for (int m = 0; m < 4; ++m) {
                const int row = EPI_ROW(ai, m); const float rs = 0.0625f * __builtin_amdgcn_rsqf(rsv[ai][m] * (1.f / DM) + EPS);
#pragma unroll
                for (int bj = 0; bj < 2; ++bj) st8(P + G_RK + (size_t)row * 1024 + cl + bj * 128, acc[ai][bj][m][0] * rs, acc[ai][bj][m][1] * rs);
            }
    }
};
struct EpiGateUp {
    static constexpr bool RESCALE = false;
    bf16_t* P; const float* ssq;
    template <int NAI> DI void run(AccRef acc, const Unit& u, int wr, int wc, int fr, int fq) const {
        const int cl = u.pn * 128 + wc * 32 + fq * 8;
        float rsv[2][4];
#pragma unroll
        for (int ai = 0; ai < NAI; ++ai)
#pragma unroll
            for (int m = 0; m < 4; ++m) rsv[ai][m] = ssq[EPI_ROW(ai, m)];
#pragma unroll
        for (int ai = 0; ai < NAI; ++ai)
#pragma unroll
            for (int m = 0; m < 4; ++m) {
                const int row = EPI_ROW(ai, m); const float rs = __builtin_amdgcn_rsqf(rsv[ai][m] * (1.f / DM) + EPS);
                const f32x4 g0 = acc[ai][0][m][0] * rs, g1 = acc[ai][0][m][1] * rs, u0 = acc[ai][1][m][0] * rs, u1 = acc[ai][1][m][1] * rs;
                st8(P + G_RV + (size_t)row * DFF + cl, g0 * sigm4(g0) * u0, g1 * sigm4(g1) * u1);
            }
    }
};
struct EpiDownFinal {
    static constexpr bool RESCALE = false;
    float* H; const float* gfin; float* xbuf; unsigned* cnt; lptr xl;
    template <int NAI> DI void run(AccRef acc, const Unit& u, int wr, int wc, int fr, int fq) const {
        static_assert(NAI == 2, "full units only");
        const int tid = threadIdx.x, wid = __builtin_amdgcn_readfirstlane(tid >> 6), lane = tid & 63;
        const int cl = u.pn * 256 + wc * 32 + fq * 8;
        LAS float* Pt = (LAS float*)xl; LAS float* St = (LAS float*)(xl + 4096); LAS unsigned* flag = (LAS unsigned*)(xl + 5120);
        f32x4 v[2][2][4][2];
#pragma unroll
        for (int ai = 0; ai < 2; ++ai)
#pragma unroll
            for (int m = 0; m < 4; ++m) { const int row = EPI_ROW(ai, m); float ss = 0.f;
#pragma unroll
                for (int bj = 0; bj < 2; ++bj) { const float* h = H + (size_t)row * DM + cl + bj * 128;
                    v[ai][bj][m][0] = *(const f32x4*)h + acc[ai][bj][m][0]; v[ai][bj][m][1] = *(const f32x4*)(h + 4) + acc[ai][bj][m][1];
                    ss += dot4(v[ai][bj][m][0]) + dot4(v[ai][bj][m][1]); }
                ss += __shfl_xor(ss, 16); ss += __shfl_xor(ss, 32);
                if (fq == 0) Pt[(ai * 128 + wr * 64 + m * 16 + fr) * 4 + wc] = ss; }
        lds_barrier();
        if (tid < 256) { const float tot = (Pt[tid * 4 + 0] + Pt[tid * 4 + 1]) + (Pt[tid * 4 + 2] + Pt[tid * 4 + 3]);
            __hip_atomic_store(xbuf + (size_t)(u.r0 + tid) * 4 + u.pn, tot, __ATOMIC_RELAXED, __HIP_MEMORY_SCOPE_AGENT);
            asm volatile("s_waitcnt vmcnt(0)" ::: "memory");
            if (lane == 0) __hip_atomic_fetch_add(cnt + 64 * u.pm, 1u, __ATOMIC_RELAXED, __HIP_MEMORY_SCOPE_AGENT); }
        if (wid == 0) { unsigned sp = 0;
            while ((unsigned)__builtin_amdgcn_readfirstlane(__hip_atomic_load(cnt + 64 * u.pm, __ATOMIC_RELAXED, __HIP_MEMORY_SCOPE_AGENT)) < 16u) { __builtin_amdgcn_s_sleep(2); if (++sp > (1u << 22)) break; }
            __builtin_amdgcn_fence(__ATOMIC_ACQUIRE, "agent");
            if (lane == 0) flag[0] = 1u; }
        asm volatile("s_waitcnt vmcnt(0)" ::: "memory");
        lds_barrier();
        if (tid < 256) { const float* sl = xbuf + (size_t)(u.r0 + tid) * 4; float q = 0.f;
#pragma unroll
            for (int t = 0; t < 4; ++t) q += __hip_atomic_load(sl + t, __ATOMIC_RELAXED, __HIP_MEMORY_SCOPE_AGENT);
            St[tid] = __builtin_amdgcn_rsqf(q * (1.f / DM) + EPS); }
        lds_barrier();
#pragma unroll
        for (int bj = 0; bj < 2; ++bj) { const f32x4 g0 = *(const f32x4*)(gfin + cl + bj * 128), g1 = *(const f32x4*)(gfin + cl + bj * 128 + 4);
#pragma unroll
            for (int ai = 0; ai < 2; ++ai)
#pragma unroll
                for (int m = 0; m < 4; ++m) { const int rl = ai * 128 + wr * 64 + m * 16 + fr; const float rs = St[rl]; float* o = H + (size_t)(u.r0 + rl) * DM + cl + bj * 128;
                    __builtin_nontemporal_store(v[ai][bj][m][0] * g0 * rs, (f32x4*)o); __builtin_nontemporal_store(v[ai][bj][m][1] * g1 * rs, (f32x4*)(o + 4)); } }
    }
};

template <class Epi>
DI void mini_gemm_phase(lptr L, const pg8::Gemm g, const int row_base, const Epi& E) {
    const int tid = threadIdx.x, wid = __builtin_amdgcn_readfirstlane(tid >> 6), lane = tid & 63, kh = wid >> 2, wc = wid & 3, fr = lane & 15, fq = lane >> 4;
    const int nN = g.N / 256, nItems = (g.M / 64) * nN, G = gridDim.x, nt = g.K / 64;
    constexpr int PB = 144, ST_A = 0, ST_B = 9216, ST_SZ = 46080;
    const int arow = tid >> 3, ach = tid & 7;
    for (int it = blockIdx.x; it < nItems; it += G) {
        const int im = it / nN, in = it % nN;
        const bf16_t* Ab = g.A + (size_t)(im * 64 + arow) * g.lda + ach * 8;
        const bf16_t* Bb = g.Bt + (size_t)(in * 256 + arow) * g.K + ach * 8;
        u32x4 ra[4], rb[4][4];
#pragma unroll
        for (int j = 0; j < 4; ++j) { ra[j] = *(const u32x4*)(Ab + j * 64);
#pragma unroll
            for (int k = 0; k < 4; ++k) rb[j][k] = *(const u32x4*)(Bb + (size_t)(64 * k) * g.K + j * 64); }
        f32x4 acc[2][2][4][2];
#pragma unroll
        for (int a = 0; a < 2; ++a)
#pragma unroll
            for (int b = 0; b < 2; ++b)
#pragma unroll
                for (int m = 0; m < 4; ++m)
#pragma unroll
                    for (int n = 0; n < 2; ++n) acc[a][b][m][n] = (f32x4){0.f, 0.f, 0.f, 0.f};
#pragma unroll 1
        for (int t = 0; t < nt; t += 4) {
            if constexpr (Epi::RESCALE) { if (t > 0) {
#pragma unroll
                for (int m = 0; m < 4; ++m) { const f32x4 fz = E.factors(row_base + im * 64 + 16 * m + fr); const float r = (t == 4) ? fz.x : (t == 8) ? fz.y : fz.z;
#pragma unroll
                    for (int bj = 0; bj < 2; ++bj)
#pragma unroll
                        for (int n = 0; n < 2; ++n) acc[0][bj][m][n] = acc[0][bj][m][n] * r; } } }
#pragma unroll
            for (int j = 0; j < 4; ++j) {
                lptr S = L + (j & 1) * ST_SZ;
                *(LAS u32x4*)(S + ST_A + arow * PB + ach * 16) = ra[j];
#pragma unroll
                for (int k = 0; k < 4; ++k) *(LAS u32x4*)(S + ST_B + (arow + 64 * k) * PB + ach * 16) = rb[j][k];
                lds_barrier();
                if (t + j + 4 < nt) { ra[j] = *(const u32x4*)(Ab + (t + j + 4) * 64);
#pragma unroll
                    for (int k = 0; k < 4; ++k) rb[j][k] = *(const u32x4*)(Bb + (size_t)(64 * k) * g.K + (t + j + 4) * 64); }
                bf16x8 af[4], bf[2][2];
#pragma unroll
                for (int m = 0; m < 4; ++m) af[m] = lds16(S + ST_A + (16 * m + fr) * PB + (32 * kh + 8 * fq) * 2);
#pragma unroll
                for (int bj = 0; bj < 2; ++bj)
#pragma unroll
                    for (int n = 0; n < 2; ++n) bf[bj][n] = lds16(S + ST_B + (128 * bj + 32 * wc + pg8::perm32(16 * n + fr)) * PB + (32 * kh + 8 * fq) * 2);
#pragma unroll
                for (int bj = 0; bj < 2; ++bj)
#pragma unroll
                    for (int m = 0; m < 4; ++m)
#pragma unroll
                        for (int n = 0; n < 2; ++n) acc[0][bj][m][n] = mfma16(bf[bj][n], af[m], acc[0][bj][m][n]);
            }
        }
        lds_barrier();
        if (kh == 1) {
#pragma unroll
            for (int bj = 0; bj < 2; ++bj)
#pragma unroll
                for (int m = 0; m < 4; ++m)
#pragma unroll
                    for (int n = 0; n < 2; ++n) *(LAS f32x4*)(L + ((wc * 16 + bj * 8 + m * 2 + n) * 64 + lane) * 16) = acc[0][bj][m][n];
        }
        lds_barrier();
        if (kh == 0) {
#pragma unroll
            for (int bj = 0; bj < 2; ++bj)
#pragma unroll
                for (int m = 0; m < 4; ++m)
#pragma unroll
                    for (int n = 0; n < 2; ++n) acc[0][bj][m][n] += *(const LAS f32x4*)(L + ((wc * 16 + bj * 8 + m * 2 + n) * 64 + lane) * 16);
            Unit u; u.pm = 0; u.pn = in; u.r0 = row_base + im * 64; u.ui = 0;
            E.template run<1>(acc, u, 0, wc, fr, fq);
        }
        lds_barrier();
    }
}
struct Params {
    const float *xp, *xs, *crs, *csk, *csv, *cmk, *cmv, *memp, *relb, *g_attn, *w_in, *w_ro, *w_so, *w_mx, *sinks, *g_cross, *g_mem, *w_cq, *w_mk, *w_mv, *w_co,
                *g_ffn, *w_gate, *w_up, *w_down, *g_final;
    float* out; unsigned char* ws; int ph_lo, ph_hi;
};

DI void transpose_item(const float* W, int N, const float* gain, bf16_t* WT, int ldk, int k0, int n0, int drow0, LAS float* scr, int lane) {
#pragma unroll 8
    for (int i = 0; i < 32; ++i) { const int kk = 2 * i + (lane >> 5); const float g = gain ? gain[k0 + kk] : 1.f; scr[kk * 33 + (lane & 31)] = W[(size_t)(k0 + kk) * N + n0 + (lane & 31)] * g; }
    asm volatile("s_waitcnt lgkmcnt(0)" ::: "memory");
    const int c = lane & 7;
#pragma unroll
    for (int j = 0; j < 4; ++j) { const int n = (lane >> 3) + 8 * j; const LAS float* s = scr + (8 * c) * 33 + n;
        u32x4 o; o.x = cvt_pk_bf16(s[0 * 33], s[1 * 33]); o.y = cvt_pk_bf16(s[2 * 33], s[3 * 33]); o.z = cvt_pk_bf16(s[4 * 33], s[5 * 33]); o.w = cvt_pk_bf16(s[6 * 33], s[7 * 33]);
        *(u32x4*)(WT + (size_t)(drow0 + n) * ldk + k0 + 8 * c) = o; }
    asm volatile("s_waitcnt lgkmcnt(0)" ::: "memory");
}
DI void row_to_bf16(const float* xrow, bf16_t* orow, float* rstd_out, int lane) {
    const f32x4* xr = (const f32x4*)xrow + lane; f32x4 v[4]; float s = 0.f;
#pragma unroll
    for (int j = 0; j < 4; ++j) { v[j] = xr[64 * j]; s += dot4(v[j]); }
    s = wave_sum(s);
    if (lane == 0) *rstd_out = 1.f / sqrtf(s * (1.f / DM) + EPS);
    u32x2* o8 = (u32x2*)orow + lane;
#pragma unroll
    for (int j = 0; j < 4; ++j) o8[64 * j] = pack4(v[j]);
}
DI void phase_prep(const Params& p, lptr L, int tid, int lane, int wave) {
    LAS float* scr = (LAS float*)(L + wave * 8448);
    const int G = gridDim.x, gw = blockIdx.x * 8 + wave, NGW = G * 8;
    unsigned char* ws = p.ws;
    constexpr int I_IN = 16 * 232, I_SQ = 512, I_FF = 16 * 88, I_DN = 44 * 32;
    constexpr int NITEMS = I_IN + 7 * I_SQ + 2 * I_FF + I_DN;
    for (int it = gw; it < NITEMS; it += NGW) {
        int r = it;
        if (r < I_IN) { const int kb = r / 232, nb = r % 232; transpose_item(p.w_in, DIN, p.g_attn, (bf16_t*)(ws + WS_WIN), DM, kb * 64, nb * 32, nb * 32, scr, lane); continue; } r -= I_IN;
        if (r < 7 * I_SQ) { const int mi = r / I_SQ, q = r % I_SQ, kb = q / 32, nb = q % 32;
            const float* W = mi == 0 ? p.w_ro : mi == 1 ? p.w_so : mi == 2 ? p.w_mx : mi == 3 ? p.w_cq : mi == 4 ? p.w_co : mi == 5 ? p.w_mk : p.w_mv;
            const float* gn = mi == 3 ? p.g_cross : (mi >= 5 ? p.g_mem : nullptr);
            bf16_t* WT = (bf16_t*)(ws + (mi == 0 ? WS_WRO : mi == 1 ? WS_WSO : mi == 2 ? WS_WMX : mi == 3 ? WS_WCQ : mi == 4 ? WS_WCO : WS_WMKV));
            transpose_item(W, DM, gn, WT, DM, kb * 64, nb * 32, (mi == 6 ? 1024 : 0) + nb * 32, scr, lane); continue; } r -= 7 * I_SQ;
        if (r < 2 * I_FF) { const int up = r / I_FF, q = r % I_FF, kb = q / 88, nb = q % 88, n0 = nb * 32;
            transpose_item(up ? p.w_up : p.w_gate, DFF, p.g_ffn, (bf16_t*)(ws + WS_WGU), DM, kb * 64, n0, 256 * (n0 / 128) + (n0 % 128) + up * 128, scr, lane); continue; } r -= 2 * I_FF;
        { const int kb = r / 32, nb = r % 32; transpose_item(p.w_down, DM, nullptr, (bf16_t*)(ws + WS_WDN), DFF, kb * 64, nb * 32, nb * 32, scr, lane); }
    }
    bf16_t* XB = (bf16_t*)((unsigned char*)p.out + OB_XB); bf16_t* MB = (bf16_t*)((unsigned char*)p.out + OB_MB);
    for (int m = 2 * gw; m < MT; m += 2 * NGW) {
        const float* xa = m < MP ? p.xp + (size_t)m * DM : p.xs + (size_t)(m - MP) * DM; const f32x4* xr = (const f32x4*)xa + lane; f32x4 v[8]; float s0 = 0.f, s1 = 0.f;
#pragma unroll
        for (int j = 0; j < 8; ++j) v[j] = xr[64 * j];
#pragma unroll
        for (int j = 0; j < 4; ++j) { s0 += dot4(v[j]); s1 += dot4(v[4 + j]); }
        s0 = wave_sum(s0); s1 = wave_sum(s1);
        if (lane == 0) { p.out[O_RSTD1 + m] = 1.f / sqrtf(s0 * (1.f / DM) + EPS); p.out[O_RSTD1 + m + 1] = 1.f / sqrtf(s1 * (1.f / DM) + EPS); }
        u32x2* o8 = (u32x2*)(XB + (size_t)m * DM) + lane;
#pragma unroll
        for (int j = 0; j < 8; ++j) o8[64 * j] = pack4(v[j]);
    }
    { bf16_t* CB = (bf16_t*)(ws + WS_CKVB);
      for (int m = gw; m < 2 * NB * NMEM; m += NGW) { const int r = m >> 1, isv = m & 1; const f32x4* src = (const f32x4*)((isv ? p.cmv : p.cmk) + (size_t)r * DM) + lane; u32x2* o8 = (u32x2*)(CB + (size_t)r * 2048 + isv * 1024) + lane;
#pragma unroll
          for (int j = 0; j < 4; ++j) o8[64 * j] = pack4(src[64 * j]); } }
    for (int m = gw; m < NB * NMEM; m += NGW) row_to_bf16(p.memp + (size_t)m * DM, MB + (size_t)m * DM, p.out + O_RSTDM + m, lane);
    const int gt = blockIdx.x * 512 + tid, GT = G * 512;
    for (int i = gt; i < 4160 * 128; i += GT) { const int pos = i >> 7, j = i & 127; const float inv = exp2f(-(float)j * (13.287712379549449f / 128.f)); const float ang = (float)pos * inv;
        float s, c; sincosf(ang, &s, &c); const h16x2 cs = {(_Float16)c, (_Float16)s}; ((unsigned*)(p.out + O_ROPE))[i] = __builtin_bit_cast(unsigned, cs); }
    float* z = (float*)(ws + WS_SSQR);
    for (int i = gt; i < MT * 7; i += GT) z[i] = 0.f;
    unsigned* xc = (unsigned*)(ws + WS_XCNT);
    for (int i = gt; i < 256 * 64; i += GT) xc[i] = 0u;
}

constexpr int R_QS = 0, R_KS = 33792, R_VS = 67584, R_VD = 77824, R_ST = 87040, R_END = 123904, QP = 528, VP = 144, VP2 = 160, QP2 = 544;
constexpr int L_BIAS = 124928;
DI void retention_stream(const Params& p, lptr L, int stream, int tid, int lane, int wave, const bool dry = false, const int pmode = 0) {
    const bool samp = stream >= 256; const int sid = stream & 255, b = sid >> 4, h = (sid >> 2) & 3, sl = sid & 3;
    const int nch = samp ? 1 : 64; const int rowb = samp ? MP + b * 64 : b * SEQ;
    bf16_t* P = (bf16_t*)(p.ws + WS_P); float* ssqr = (float*)(p.ws + WS_SSQR);
    const int l15 = lane & 15, g4 = lane >> 4;
    const float l2g = log2f(1.f - exp2f(-5.f - (float)h));
    const float g64 = ex2(64.f * l2g);
    const int nt = wave >> 1, mtb = 2 * (wave & 1);
    const int vrow = tid >> 3, vch = tid & 7;
    const float vdec = ex2((float)(63 - vrow) * l2g);
    u32x4 pq[4], pk[4], pv; u32x2 rgc[2];
    const bf16_t* Qb = P + G_RQ + (size_t)rowb * 1024 + h * 256; const bf16_t* Kb = Qb + GSZ;
    bf16_t* Vb = P + G_RV + (size_t)rowb * 1024 + h * 256 + sl * 64; const bf16_t* Rb = P + G_RG + (size_t)rowb * 1024 + h * 256 + sl * 64;
    const unsigned qoff = (unsigned)((tid >> 5) * 1024 + (tid & 31) * 8), voff = (unsigned)(vrow * 1024 + vch * 8), ooff = (unsigned)((16 * nt + l15) * 1024 + 16 * mtb + 4 * g4);
    auto gload = [&](int ch) {
        const unsigned c0 = (unsigned)ch * 65536u;
#pragma unroll
        for (int k = 0; k < 4; ++k) { pq[k] = *(const u32x4*)(Qb + (c0 + qoff + k * 16384u)); pk[k] = *(const u32x4*)(Kb + (c0 + qoff + k * 16384u)); }
        pv = *(const u32x4*)(Vb + (c0 + voff));
    };
    auto gload_rg = [&](int ch) {
#pragma unroll
        for (int mi = 0; mi < 2; ++mi) rgc[mi] = *(const u32x2*)(Rb + ((unsigned)ch * 65536u + ooff + 16 * mi));
    };
    gload(0); gload_rg(0);
    f32x4 accSt[4][2];
    float* sout = p.out + (samp ? O_RSS : O_RSP) + ((size_t)(b * 4 + h) * 256) * 256 + sl * 64;
    const float* sin_ = p.crs + ((size_t)(b * 4 + h) * 256) * 256 + sl * 64;
#pragma unroll
    for (int mt4 = 0; mt4 < 4; ++mt4)
#pragma unroll
        for (int ni = 0; ni < 2; ++ni) {
            const int dk = 32 * wave + 16 * ni + l15, dv = 16 * mt4 + 4 * g4;
            accSt[mt4][ni] = samp ? *(const f32x4*)(sin_ + (size_t)dk * 256 + dv) : (f32x4){0.f, 0.f, 0.f, 0.f};
            *(LAS u32x2*)(L + R_ST + dk * VP + dv * 2) = pack4(accSt[mt4][ni]);
        }
    for (int ch = 0; ch < nch; ++ch) {
#pragma unroll
        for (int k = 0; k < 4; ++k) { const int c = tid + 512 * k, row = c >> 5, cc = c & 31; *(LAS u32x4*)(L + R_QS + row * QP + cc * 16) = pq[k]; *(LAS u32x4*)(L + R_KS + row * QP + cc * 16) = pk[k]; }
        *(LAS u32x4*)(L + R_VS + vrow * VP2 + vch * 16) = pv;
        { f32x4 a, c2; a.x = bf_lo(pv.x) * vdec; a.y = bf_hi(pv.x) * vdec; a.z = bf_lo(pv.y) * vdec; a.w = bf_hi(pv.y) * vdec; c2.x = bf_lo(pv.z) * vdec; c2.y = bf_hi(pv.z) * vdec; c2.z = bf_lo(pv.w) * vdec; c2.w = bf_hi(pv.w) * vdec;
          *(LAS bf16x8*)(L + R_VD + vrow * VP + vch * 16) = pack8(a, c2); }
        lds_barrier();
        if (ch + 1 < nch) gload(ch + 1);
        if (pmode != 2) {
        bf16x8 qf[8];
#pragma unroll
        for (int ks = 0; ks < 8; ++ks) qf[ks] = lds16(L + R_QS + (16 * nt + l15) * QP + (32 * ks + 8 * g4) * 2);
        f32x4 accS[4];
#pragma unroll
        for (int jt = 0; jt < 4; ++jt) { accS[jt] = (f32x4){0.f, 0.f, 0.f, 0.f};
#pragma unroll
            for (int ks = 0; ks < 8; ++ks) accS[jt] = mfma16(lds16(L + R_KS + (16 * jt + l15) * QP + (32 * ks + 8 * g4) * 2), qf[ks], accS[jt]); }
        const int il = 16 * nt + l15;
#pragma unroll
        for (int jt = 0; jt < 4; ++jt) { const int j0 = 16 * jt + 4 * g4;
            accS[jt].x *= ex2(fabsf((float)(il - j0)) * l2g); accS[jt].y *= ex2(fabsf((float)(il - j0 - 1)) * l2g);
            accS[jt].z *= ex2(fabsf((float)(il - j0 - 2)) * l2g); accS[jt].w *= ex2(fabsf((float)(il - j0 - 3)) * l2g); }
        bf16x8 pS[2]; pS[0] = pack8(accS[0], accS[1]); pS[1] = pack8(accS[2], accS[3]);
        const float qdec = ex2((float)(il + 1) * l2g);
        const size_t orow = (size_t)(rowb + ch * 64 + il);
        float ssq = 0.f;
#pragma unroll
        for (int mi = 0; mi < 2; ++mi) { const int mt = mtb + mi; const int cb = (16 * mt + 4 * (l15 & 3)) * 2;
            f32x4 aI = (f32x4){0.f, 0.f, 0.f, 0.f}, aC = (f32x4){0.f, 0.f, 0.f, 0.f};
#pragma unroll
            for (int kk = 0; kk < 2; ++kk) { lptr v0 = L + R_VS + (32 * kk + 4 * g4 + (l15 >> 2)) * VP2 + cb; aI = mfma16(tr_pair(v0, v0 + 16 * VP2), pS[kk], aI); }
#pragma unroll
            for (int ks = 0; ks < 8; ++ks) { lptr s0 = L + R_ST + (32 * ks + 8 * g4 + (l15 >> 2)) * VP + cb; aC = mfma16(tr_pair(s0, s0 + 4 * VP), qf[ks], aC); }
            const f32x4 o = aI + aC * qdec;
            const f32x4 og = (f32x4){o.x * bf_lo(rgc[mi].x), o.y * bf_hi(rgc[mi].x), o.z * bf_lo(rgc[mi].y), o.w * bf_hi(rgc[mi].y)};
            if (!dry || o.x == 1.2345e30f) *(u32x2*)(Vb + ((unsigned)ch * 65536u + ooff + 16 * mi)) = pack4(og);
            ssq += dot4(o); }
        if (ch + 1 < nch) gload_rg(ch + 1);
        ssq += __shfl_xor(ssq, 16); ssq += __shfl_xor(ssq, 32);
        if (g4 == 0 && (!dry || ssq == 1.2345e30f)) unsafeAtomicAdd(ssqr + orow * 4 + h, ssq);
        }
        if (pmode != 1) {
#pragma unroll
        for (int mt4 = 0; mt4 < 4; ++mt4)
#pragma unroll
            for (int ni = 0; ni < 2; ++ni) accSt[mt4][ni] = accSt[mt4][ni] * g64;
#pragma unroll
        for (int kk = 0; kk < 2; ++kk) { const int r0 = 32 * kk + 8 * g4 + (l15 >> 2);
            bf16x8 bfr[2];
#pragma unroll
            for (int ni = 0; ni < 2; ++ni) { lptr k0 = L + R_KS + r0 * QP + (32 * wave + 16 * ni + 4 * (l15 & 3)) * 2; bfr[ni] = tr_pair(k0, k0 + 4 * QP); }
#pragma unroll
            for (int mt4 = 0; mt4 < 4; ++mt4) { lptr v0 = L + R_VD + r0 * VP + (16 * mt4 + 4 * (l15 & 3)) * 2; const bf16x8 afr = tr_pair(v0, v0 + 4 * VP);
#pragma unroll
                for (int ni = 0; ni < 2; ++ni) accSt[mt4][ni] = mfma16(afr, bfr[ni], accSt[mt4][ni]); } }
        }
        lds_barrier();
#pragma unroll
        for (int mt4 = 0; mt4 < 4; ++mt4)
#pragma unroll
            for (int ni = 0; ni < 2; ++ni) *(LAS u32x2*)(L + R_ST + (32 * wave + 16 * ni + l15) * VP + (16 * mt4 + 4 * g4) * 2) = pack4(accSt[mt4][ni]);
    }
#pragma unroll
    for (int mt4 = 0; mt4 < 4; ++mt4)
#pragma unroll
        for (int ni = 0; ni < 2; ++ni) if (!dry || accSt[mt4][ni].x == 1.2345e30f) *(f32x4*)(sout + (size_t)(32 * wave + 16 * ni + l15) * 256 + 16 * mt4 + 4 * g4) = accSt[mt4][ni];
}

constexpr int S_KS = 0, S_VS = 27648;
DI void swa_build_bias(const Params& p, lptr L, int tid) {
    LAS float* bl = (LAS float*)(L + L_BIAS);
    for (int i = tid; i < 16 * 256; i += 512) { const int hq = i >> 8, idx = i & 255; const int rel = idx - 191; const int n = rel < 0 ? -rel : rel;
        int large = 2 + (31 - __builtin_clz((unsigned)(n * n) | 1u)); large = large < 15 ? large : 15;
        const int bucket = (rel > 0 ? 16 : 0) + (n < 8 ? n : large);
        bl[i] = p.relb[bucket * 16 + hq]; }
}
struct SwaU { int b, n, kvh, row0; bool samp; };
DI SwaU swa_decode(int unit) { SwaU u; u.samp = unit >= 2048; if (!u.samp) { u.b = unit >> 7; u.n = (unit >> 1) & 63; } else { u.b = (unit - 2048) >> 1; u.n = 2; } u.kvh = unit & 1;
    u.row0 = u.samp ? MP + u.b * 64 : u.b * SEQ + u.n * 64; return u; }
DI void swa_gload(const Params& p, const SwaU& u, int tid, u32x4 (&kr)[3], u32x4 (&vr)[3]) {
    const bf16_t* P = (const bf16_t*)(p.ws + WS_P);
#pragma unroll
    for (int k = 0; k < 3; ++k) { const int c = tid + 512 * k, row = c >> 3, cc = c & 7; kr[k] = (u32x4){0u, 0u, 0u, 0u}; vr[k] = kr[k];
        if (u.n * 64 - 128 + row >= 0) { const bf16_t* src = P + G_SKV + (size_t)(u.row0 - 128 + row) * 256 + u.kvh * 64 + cc * 8; kr[k] = *(const u32x4*)src; vr[k] = *(const u32x4*)(src + 128); } }
}
DI void swa_stage_sample(const Params& p, lptr L, const SwaU& u, int tid) {
    const bf16_t* P = (const bf16_t*)(p.ws + WS_P);
#pragma unroll 1
    for (int k = 0; k < 3; ++k) { const int c = tid + 512 * k, row = c >> 3, cc = c & 7; u32x4 kv, vv;
        if (row < 128) { const size_t o = ((size_t)(u.b * 128 + row) * 2 + u.kvh) * 64 + cc * 8;
            kv = __builtin_bit_cast(u32x4, pack8(*(const f32x4*)(p.csk + o), *(const f32x4*)(p.csk + o + 4))); vv = __builtin_bit_cast(u32x4, pack8(*(const f32x4*)(p.csv + o), *(const f32x4*)(p.csv + o + 4))); }
        else { const bf16_t* src = P + G_SKV + (size_t)(u.row0 - 128 + row) * 256 + u.kvh * 64 + cc * 8; kv = *(const u32x4*)src; vv = *(const u32x4*)(src + 128); }
        *(LAS u32x4*)(L + S_KS + row * VP + cc * 16) = kv; *(LAS u32x4*)(L + S_VS + row * VP2 + cc * 16) = vv; }
}
DI void swa_phase(const Params& p, lptr L, int tid, int lane, int wave, const bool dry = false) {
    bf16_t* P = (bf16_t*)(p.ws + WS_P);
    const int G = gridDim.x, NU = 2048 + 32; const int l15 = lane & 15, g4 = lane >> 4;
    int unit = blockIdx.x; if (unit >= NU) return;
    u32x4 kr[3], vr[3];
    SwaU u = swa_decode(unit);
    for (; unit < NU; unit += G) {
        u = swa_decode(unit);
        const int hq = u.kvh * 8 + wave; const float sink = p.sinks[hq];
        bf16_t* qbase = P + G_SQ + (size_t)(u.row0 + l15) * 1024 + hq * 64;
        bf16x8 qn0 = *(const bf16x8*)(qbase + 8 * g4), qn1 = *(const bf16x8*)(qbase + 32 + 8 * g4);
        lds_barrier();
        if (u.samp) swa_stage_sample(p, L, u, tid);
        else { swa_gload(p, u, tid, kr, vr);
#pragma unroll
            for (int k = 0; k < 3; ++k) { const int c = tid + 512 * k, row = c >> 3, cc = c & 7; *(LAS u32x4*)(L + S_KS + row * VP + cc * 16) = kr[k]; *(LAS u32x4*)(L + S_VS + row * VP2 + cc * 16) = vr[k]; } }
        lds_barrier();
        const LAS float* bl = (const LAS float*)(L + L_BIAS) + hq * 256;
        const int kmin = 128 - u.n * 64;
#pragma unroll 1
        for (int qb = 0; qb < 4; ++qb) {
            const int iq = qb * 16 + l15; bf16_t* qp = qbase + (size_t)qb * 16 * 1024;
            const bf16x8 q0 = qn0, q1 = qn1;
            if (qb < 3) { qn0 = *(const bf16x8*)(qp + (size_t)16 * 1024 + 8 * g4); qn1 = *(const bf16x8*)(qp + (size_t)16 * 1024 + 32 + 8 * g4); }
            f32x4 s[12]; float mx = -3.0e38f;
#pragma unroll
            for (int tg = 0; tg < 12; tg += 4) {
                bf16x8 kf[4][2]; f32x4 bb[4];
#pragma unroll
                for (int t4 = 0; t4 < 4; ++t4) { const int t = tg + t4;
                    kf[t4][0] = lds16(L + S_KS + (16 * t + l15) * VP + (8 * g4) * 2); kf[t4][1] = lds16(L + S_KS + (16 * t + l15) * VP + (32 + 8 * g4) * 2);
                    const int bi = 16 * t + 4 * g4 + 63 - iq; bb[t4] = (f32x4){bl[bi], bl[bi + 1], bl[bi + 2], bl[bi + 3]}; }
                __builtin_amdgcn_sched_barrier(0);
#pragma unroll
                for (int t4 = 0; t4 < 4; ++t4) { const int t = tg + t4;
                    s[t] = mfma16(kf[t4][0], q0, (f32x4){0.f, 0.f, 0.f, 0.f}); s[t] = mfma16(kf[t4][1], q1, s[t]); }
#pragma unroll
                for (int t4 = 0; t4 < 4; ++t4) { const int t = tg + t4; const int key = 16 * t + 4 * g4;
                    s[t] = s[t] + bb[t4];
                    if (kmin > 0) { if (key < kmin) s[t].x = -1e30f; if (key + 1 < kmin) s[t].y = -1e30f; if (key + 2 < kmin) s[t].z = -1e30f; if (key + 3 < kmin) s[t].w = -1e30f; }
                    mx = fmaxf(mx, fmaxf(fmaxf(s[t].x, s[t].y), fmaxf(s[t].z, s[t].w))); }
                __builtin_amdgcn_sched_barrier(0);
            }
            mx = fmaxf(mx, __shfl_xor(mx, 16)); mx = fmaxf(mx, __shfl_xor(mx, 32)); mx = fmaxf(mx, sink);
            float sum = 0.f; const float mb = mx * LOG2E;
#pragma unroll
            for (int t = 0; t < 12; ++t) { s[t].x = ex2(s[t].x * LOG2E - mb); s[t].y = ex2(s[t].y * LOG2E - mb); s[t].z = ex2(s[t].z * LOG2E - mb); s[t].w = ex2(s[t].w * LOG2E - mb);
                sum += (s[t].x + s[t].y) + (s[t].z + s[t].w); }
            sum += __shfl_xor(sum, 16); sum += __shfl_xor(sum, 32);
            const float inv = 1.f / (sum + ex2(sink * LOG2E - mb));
            f32x4 o[4];
#pragma unroll
            for (int mt = 0; mt < 4; ++mt) o[mt] = (f32x4){0.f, 0.f, 0.f, 0.f};
#pragma unroll
            for (int kk = 0; kk < 6; ++kk) { const bf16x8 pf = pack8(s[2 * kk] * inv, s[2 * kk + 1] * inv);
#pragma unroll
                for (int mt = 0; mt < 4; ++mt) { lptr v0 = L + S_VS + (32 * kk + 4 * g4 + (l15 >> 2)) * VP2 + (16 * mt + 4 * (l15 & 3)) * 2; o[mt] = mfma16(tr_pair(v0, v0 + 16 * VP2), pf, o[mt]); }
                if (kk & 1) __builtin_amdgcn_sched_barrier(0); }
#pragma unroll
            for (int mt = 0; mt < 4; ++mt) if (!dry || o[mt].x == 1.2345e30f) *(u32x2*)(qp + 16 * mt + 4 * g4) = pack4(o[mt]);
        }
    }
    __syncthreads();
}

DI int cross_unit_of(int item, int c, int G) { if (G != 256) return item * G + c; if (item < 8) return ((8 * item + (c & 7)) << 5) + (c >> 3); return (item == 8 && c < 64) ? 2048 + c : -1; }
struct CrU { int b, hh, row0, nq; const bf16_t* Kg; const bf16_t* Vg; };
DI CrU cross_decode(const Params& p, int unit) { CrU u; const bool samp = unit >= 2048;
    if (!samp) { u.b = unit >> 7; u.hh = (unit >> 5) & 3; u.row0 = u.b * SEQ + (unit & 31) * 128; u.nq = 128; } else { const int u2 = unit - 2048; u.b = u2 >> 2; u.hh = u2 & 3; u.row0 = MP + u.b * 64; u.nq = 64; }
    u.Kg = (const bf16_t*)(p.ws + (samp ? WS_CKVB : WS_MKVB)) + (size_t)u.b * 256 * 2048 + u.hh * 256; u.Vg = u.Kg + 1024; return u; }
constexpr int CR_BUF = 34816;
DI const bf16_t* cross_blk(const CrU& u, int j) { return (j < 4 ? u.Kg : u.Vg) + (size_t)((j & 3) * 64) * 2048; }
DI void cross_gload(const bf16_t* src, int tid, u32x4 (&r)[4]) {
#pragma unroll
    for (int k = 0; k < 4; ++k) { const int c = tid + 512 * k, row = c >> 5, cc = c & 31; r[k] = *(const u32x4*)(src + (size_t)row * 2048 + cc * 8); }
}
DI void cross_swrite(lptr B, int tid, const u32x4 (&r)[4], const int pitch) {
#pragma unroll
    for (int k = 0; k < 4; ++k) { const int c = tid + 512 * k, row = c >> 5, cc = c & 31; *(LAS u32x4*)(B + row * pitch + cc * 16) = r[k]; }
}
DI void cross_phase(const Params& p, lptr L, int tid, int lane, int wave, const bool dry = false, const int pmode = 0) {
    bf16_t* P = (bf16_t*)(p.ws + WS_P);
    const int G = gridDim.x, NU = 2048 + 64, cbk = blockIdx.x; const int l15 = lane & 15, g4 = lane >> 4;
    int item = 0, unit = cross_unit_of(0, cbk, G); if (unit < 0 || unit >= NU) return;
    u32x4 pre[4];
    CrU u = cross_decode(p, unit);
    cross_gload(cross_blk(u, 0), tid, pre); cross_swrite(L, tid, pre, QP);
    cross_gload(cross_blk(u, 1), tid, pre);
    for (;;) {
        const int unext = cross_unit_of(item + 1, cbk, G); const bool has_next = unext >= 0 && unext < NU;
        CrU un = u; if (has_next) un = cross_decode(p, unext);
        const bool active = wave * 16 < u.nq && pmode != 1;
        bf16_t* qp = P + G_RK + (size_t)(u.row0 + (wave * 16 < u.nq ? wave * 16 + l15 : 0)) * 1024 + u.hh * 256;
        bf16x8 qf[8];
#pragma unroll
        for (int ks = 0; ks < 8; ++ks) qf[ks] = *(const bf16x8*)(qp + 32 * ks + 8 * g4);
        f32x4 s[16];
#pragma unroll
        for (int t = 0; t < 16; ++t) s[t] = (f32x4){0.f, 0.f, 0.f, 0.f};
        bf16x8 pf[8];
        f32x4 o[16];
#pragma unroll
        for (int i = 0; i < 8; ++i) {
            lds_barrier();
            lptr cur = L + (i & 1) * CR_BUF, oth = L + ((i + 1) & 1) * CR_BUF;
            if (pmode != 2) {
                if (i < 7 || has_next) cross_swrite(oth, tid, pre, (i + 1) & 4 ? QP2 : QP);
                if (i < 6) cross_gload(cross_blk(u, i + 2), tid, pre); else if (has_next) cross_gload(cross_blk(un, i - 6), tid, pre);
            }
            if (i < 4) {
                if (active) {
#pragma unroll
                    for (int t = 0; t < 4; ++t)
#pragma unroll
                        for (int ks = 0; ks < 8; ++ks) s[i * 4 + t] = mfma16(lds16(cur + (16 * t + l15) * QP + (32 * ks + 8 * g4) * 2), qf[ks], s[i * 4 + t]);
                }
                if (i == 3) {
                    float mx = -3.0e38f;
#pragma unroll
                    for (int t = 0; t < 16; ++t) mx = fmaxf(mx, fmaxf(fmaxf(s[t].x, s[t].y), fmaxf(s[t].z, s[t].w)));
                    mx = fmaxf(mx, __shfl_xor(mx, 16)); mx = fmaxf(mx, __shfl_xor(mx, 32));
                    float sum = 0.f; const float mb = mx * LOG2E;
#pragma unroll
                    for (int t = 0; t < 16; ++t) { s[t].x = ex2(s[t].x * LOG2E - mb); s[t].y = ex2(s[t].y * LOG2E - mb); s[t].z = ex2(s[t].z * LOG2E - mb); s[t].w = ex2(s[t].w * LOG2E - mb);
                        sum += (s[t].x + s[t].y) + (s[t].z + s[t].w); }
                    sum += __shfl_xor(sum, 16); sum += __shfl_xor(sum, 32);
                    const float inv = 1.f / sum;
#pragma unroll
                    for (int kk = 0; kk < 8; ++kk) pf[kk] = pack8(s[2 * kk] * inv, s[2 * kk + 1] * inv);
#pragma unroll
                    for (int mt = 0; mt < 16; ++mt) o[mt] = (f32x4){0.f, 0.f, 0.f, 0.f};
                }
            } else {
                const int vb = i - 4;
                if (active) {
#pragma unroll
                    for (int k2 = 0; k2 < 2; ++k2)
#pragma unroll
                        for (int mt = 0; mt < 16; ++mt) { lptr v0 = cur + (32 * k2 + 4 * g4 + (l15 >> 2)) * QP2 + (16 * mt + 4 * (l15 & 3)) * 2; o[mt] = mfma16(tr_pair(v0, v0 + 16 * QP2), pf[2 * vb + k2], o[mt]); }
                }
            }
        }
        if (active) {
#pragma unroll
            for (int mt = 0; mt < 16; ++mt) if (!dry || o[mt].x == 1.2345e30f) *(u32x2*)(qp + 16 * mt + 4 * g4) = pack4(o[mt]);
        }
        if (!has_next) break;
        unit = unext; ++item; u = un;
    }
    __syncthreads();
}
DI void pass_final(const Params& p, int lane, int wave, const int row_lo) {
    const float* ssq = (const float*)(p.ws + WS_SSQ4);
    const int gw = blockIdx.x * 8 + wave, NGW = gridDim.x * 8;
    f32x4 g[4];
#pragma unroll
    for (int j = 0; j < 4; ++j) g[j] = *((const f32x4*)p.g_final + lane + 64 * j);
    for (int m = row_lo + gw; m < MT; m += NGW) { const float rs = 1.f / sqrtf(ssq[m] * (1.f / DM) + EPS); f32x4* h = (f32x4*)(p.out + (size_t)m * DM) + lane;
#pragma unroll
        for (int j = 0; j < 4; ++j) h[64 * j] = h[64 * j] * g[j] * rs; }
}
DI void pass_swa_cache_out(const Params& p, int tid) {
    const bf16_t* P = (const bf16_t*)(p.ws + WS_P);
    const int gt = blockIdx.x * 512 + tid, GT = gridDim.x * 512;
    for (int i = gt; i < 4 * 262144; i += GT) { const int which = i >> 18, r = i & 262143, b = r >> 14, j = (r >> 7) & 127, c = r & 127;
        const bool isv = which >= 2, samp = which & 1; float v;
        if (!samp) v = bf_lo((unsigned)P[G_SKV + (size_t)(b * SEQ + SEQ - 128 + j) * 256 + (isv ? 128 : 0) + c]);
        else if (j < 64) v = (isv ? p.csv : p.csk)[(size_t)(b * 128 + 64 + j) * 128 + c];
        else v = bf_lo((unsigned)P[G_SKV + (size_t)(MP + b * 64 + j - 64) * 256 + (isv ? 128 : 0) + c]);
        p.out[(which == 0 ? O_KP : which == 1 ? O_KS : which == 2 ? O_VP : O_VS) + r] = v; }
}


#define XB_TMO      128
#define XB_XCNT(j)  (256  + 64 * (j))
#define XB_XSUB(j)  (1280 + 64 * (j))
#define XB_XGEN(j)  (2304 + 64 * (j))
#define XB_TOP      3328
#define XB_TOPGEN   3392
#define XCD_BAR_WORDS 3456
#define XB_SPIN_CAP (1u << 18)
constexpr size_t WS_BAR = 1900544;
static_assert(WS_BAR >= WS_ZEND && WS_BAR + XCD_BAR_WORDS * 4 <= WS_WIN && WS_BAR % 256 == 0, "barrier words");
constexpr int L_MISC = 141312;
DI unsigned xb_ld(unsigned* p)              { return __hip_atomic_load(p, __ATOMIC_RELAXED, __HIP_MEMORY_SCOPE_AGENT); }
DI unsigned xb_add(unsigned* p, unsigned v) { return __hip_atomic_fetch_add(p, v, __ATOMIC_RELAXED, __HIP_MEMORY_SCOPE_AGENT); }
DI unsigned xb_xcc_id() { return (unsigned)__builtin_amdgcn_s_getreg((3 << 11) | 20) & 0xFu; }
#define XB_SPIN(cond, bar) do { unsigned _sp = 0; while (cond) { __builtin_amdgcn_s_sleep(1); \
    if ((++_sp & 255u) == 0u) { if (xb_ld(&(bar)[XB_TMO])) break; if (_sp > XB_SPIN_CAP) { atomicAdd(&(bar)[XB_TMO], 1u); break; } } } } while (0)
struct XcdBarrier { unsigned* bar; unsigned x; volatile LAS unsigned* st; };
DI XcdBarrier xcd_barrier_post(unsigned* bar, volatile LAS unsigned* st) {
    XcdBarrier b; b.bar = bar; b.x = xb_xcc_id(); b.st = st;
    if (threadIdx.x == 0) (void)xb_add(&bar[XB_XCNT(b.x)], 1u);
    return b;
}
DI void xcd_barrier_complete(unsigned* bar, unsigned x, unsigned& nloc, unsigned& nx) {
    const unsigned G = gridDim.x * gridDim.y * gridDim.z;
    unsigned sum, cnt, mine, sp = 0u;
    for (;;) {
        sum = 0u; cnt = 0u; mine = 0u;
#pragma unroll
        for (unsigned j = 0; j < 16; ++j) { const unsigned c = xb_ld(&bar[XB_XCNT(j)]); sum += c; cnt += (c > 0u) ? 1u : 0u; mine = (j == x) ? c : mine; }
        if (sum == G) break;
        __builtin_amdgcn_s_sleep(1);
        if ((++sp & 255u) == 0u) { if (xb_ld(&bar[XB_TMO])) break; if (sp > XB_SPIN_CAP) { atomicAdd(&bar[XB_TMO], 1u); break; } }
    }
    nloc = mine > 0u ? mine : 1u; nx = cnt > 0u ? cnt : 1u;
}
DI void xcd_barrier(const XcdBarrier& b) {
    asm volatile("s_waitcnt vmcnt(0)" ::: "memory");
    __syncthreads();
    if (threadIdx.x == 0) {
        unsigned* bar = b.bar;
        __builtin_amdgcn_s_waitcnt(0);
        unsigned nloc = b.st[0], nx = b.st[1];
        if (nloc == 0u) { xcd_barrier_complete(bar, b.x, nloc, nx); b.st[0] = nloc; b.st[1] = nx; }
        const unsigned old = xb_add(&bar[XB_XSUB(b.x)], 1u);
        const unsigned gen = old / nloc;
        if (old + 1u == (gen + 1u) * nloc) {
            __builtin_amdgcn_fence(__ATOMIC_RELEASE, "agent");
            asm volatile("s_waitcnt vmcnt(0)" ::: "memory");
            const unsigned og = xb_add(&bar[XB_TOP], 1u);
            const unsigned tg = og / nx;
            if (og + 1u == (tg + 1u) * nx) xb_add(&bar[XB_TOPGEN], 1u);
            else XB_SPIN(xb_ld(&bar[XB_TOPGEN]) == tg, bar);
            __builtin_amdgcn_fence(__ATOMIC_ACQUIRE, "agent");
            xb_add(&bar[XB_XGEN(b.x)], 1u);
            asm volatile("s_waitcnt vmcnt(0)" ::: "memory");
        } else {
            XB_SPIN(xb_ld(&bar[XB_XGEN(b.x)]) == gen, bar);
            __builtin_amdgcn_fence(__ATOMIC_ACQUIRE, "agent");
            asm volatile("s_waitcnt vmcnt(0)" ::: "memory");
        }
    }
    __syncthreads();
}

constexpr int N_PHASES = 12;
#ifndef PROBE_PHASE
#define PROBE_PHASE 0
#endif
__global__ void __launch_bounds__(512, 2) fwd_mega(Params p) {
    extern __shared__ __attribute__((aligned(16))) unsigned char lds_raw[];
    lptr L = (lptr)lds_raw;
    const int tid = threadIdx.x, lane = tid & 63, wave = __builtin_amdgcn_readfirstlane(tid >> 6);
    const int G = gridDim.x, cb = blockIdx.x;
    unsigned char* ws = p.ws; bf16_t* P = (bf16_t*)(ws + WS_P);
    const int lo = p.ph_lo, hi = p.ph_hi;
#define IN(k) (lo <= (k) && (k) < hi)
    if (tid < 2) ((volatile LAS unsigned*)(L + L_MISC))[tid] = 0u;
    __syncthreads();
    const XcdBarrier xbar = xcd_barrier_post((unsigned*)(ws + WS_BAR), (volatile LAS unsigned*)(L + L_MISC));
#define SEAM(k) do { if (IN(k) && IN((k) + 1)) xcd_barrier(xbar); } while (0)
    if (lo < 0) cg::this_grid().sync();
#if PROBE_PHASE == 5
    for (int i = 0; i < 10; ++i) cg::this_grid().sync();
#endif
#if PROBE_PHASE == 6
    phase_prep(p, L, tid, lane, wave);
#endif
    if (IN(0)) { phase_prep(p, L, tid, lane, wave); }
    SEAM(0);
    if (IN(1)) {
#if PROBE_PHASE == 4
        { pg8::Gemm g{(const bf16_t*)((unsigned char*)p.out + OB_XB), DM, (const bf16_t*)(ws + WS_WIN), MT, DIN, DM}; pg8::StaticOrder S; S.init(MT, DIN, G, cb);
          EpiInProj E{P, p.out + O_RSTD1, (const unsigned*)(p.out + O_ROPE)}; pg8::gemm_phase<EpiInProj, true>(L, g, S, E); }
#endif
        { pg8::Gemm g{(const bf16_t*)((unsigned char*)p.out + OB_XB), DM, (const bf16_t*)(ws + WS_WIN), MT, DIN, DM}; pg8::StaticOrder S; S.init(MT, DIN, G, cb);
          EpiInProj E{P, p.out + O_RSTD1, (const unsigned*)(p.out + O_ROPE)}; pg8::gemm_phase<EpiInProj, true>(L, g, S, E); }
        { const int r = ((MT / 256) * (DIN / 256)) % G; const int c2 = (cb - r + G) % G;
          pg8::Gemm g{(const bf16_t*)((unsigned char*)p.out + OB_MB), DM, (const bf16_t*)(ws + WS_WMKV), NB * NMEM, 2048, DM}; pg8::StaticOrder S; S.init(NB * NMEM, 2048, G, c2);
          EpiMemKV E{p.out + O_MK, p.out + O_MV, p.out + O_RSTDM, (bf16_t*)(ws + WS_MKVB)}; pg8::gemm_phase<EpiMemKV, true>(L, g, S, E); }
    }
    SEAM(1);
    if (IN(2)) {
        swa_build_bias(p, L, tid);
        pass_swa_cache_out(p, tid);
#if PROBE_PHASE == 1
        for (int s = cb; s < 512; s += G) retention_stream(p, L, s, tid, lane, wave, true);
        __syncthreads();
#endif
#if PROBE_PHASE == 10
        for (int s = cb; s < 512; s += G) retention_stream(p, L, s, tid, lane, wave, true, 1);
        __syncthreads();
#endif
#if PROBE_PHASE == 11
        for (int s = cb; s < 512; s += G) retention_stream(p, L, s, tid, lane, wave, true, 2);
        __syncthreads();
#endif
#if PROBE_PHASE == 2
        swa_phase(p, L, tid, lane, wave, true);
#endif
        for (int s = cb; s < 512; s += G) { int st = s; if (G == 256) { const int c = s & 255; st = (s & 256) | ((((c & 7) + 8 * (c >> 5)) << 2) | ((c >> 3) & 3)); }
            retention_stream(p, L, st, tid, lane, wave); }
        __syncthreads();
        swa_phase(p, L, tid, lane, wave);
    }
    SEAM(2);
    if (IN(3)) {
        pg8::Gemm g{P + G_SQ, DM, (const bf16_t*)(ws + WS_WSO), MP, DM, DM}; pg8::StaticOrder S; S.init(MP, DM, G, cb);
        EpiSwaOut E{P}; pg8::gemm_phase<EpiSwaOut, true>(L, g, S, E);
        pg8::Gemm gs{P + G_SQ + (size_t)MP * DM, DM, (const bf16_t*)(ws + WS_WSO), MS, DM, DM}; mini_gemm_phase<EpiSwaOut>(L, gs, MP, E);
        {
        pg8::Gemm g{P + G_RV, DM, (const bf16_t*)(ws + WS_WRO), MP, DM, DM}; pg8::StaticOrder S; S.init(MP, DM, G, cb);
        EpiRetOut E{P, (const float*)(ws + WS_SSQR), L + 131072}; pg8::gemm_phase<EpiRetOut, true>(L, g, S, E);
        pg8::Gemm gs{P + G_RV + (size_t)MP * DM, DM, (const bf16_t*)(ws + WS_WRO), MS, DM, DM}; mini_gemm_phase<EpiRetOut>(L, gs, MP, E);
        }
    }
    SEAM(3);
    if (IN(5)) {
        pg8::Gemm g{P + G_GA, DM, (const bf16_t*)(ws + WS_WMX), MP, DM, DM}; pg8::StaticOrder S; S.init(MP, DM, G, cb);
        EpiResid<true, true> E{p.xp, p.xs, p.out, P, (float*)(ws + WS_SSQ2)}; pg8::gemm_phase<EpiResid<true, true>, true>(L, g, S, E);
        pg8::Gemm gs{P + G_GA + (size_t)MP * DM, DM, (const bf16_t*)(ws + WS_WMX), MS, DM, DM}; mini_gemm_phase<EpiResid<true, true>>(L, gs, MP, E);
    }
    SEAM(5);
    if (IN(6)) {
#if PROBE_PHASE == 9
        { pg8::Gemm g{P + G_RQ, DM, (const bf16_t*)(ws + WS_WCQ), MP, DM, DM}; pg8::StaticOrder S; S.init(MP, DM, G, cb);
          EpiCq E{P, (const float*)(ws + WS_SSQ2)}; pg8::gemm_phase<EpiCq, true>(L, g, S, E); }
#endif
        pg8::Gemm g{P + G_RQ, DM, (const bf16_t*)(ws + WS_WCQ), MP, DM, DM}; pg8::StaticOrder S; S.init(MP, DM, G, cb);
        EpiCq E{P, (const float*)(ws + WS_SSQ2)}; pg8::gemm_phase<EpiCq, true>(L, g, S, E);
        pg8::Gemm gs{P + G_RQ + (size_t)MP * DM, DM, (const bf16_t*)(ws + WS_WCQ), MS, DM, DM}; mini_gemm_phase<EpiCq>(L, gs, MP, E);
    }
    SEAM(6);
    if (IN(7)) {
#if PROBE_PHASE == 3
        cross_phase(p, L, tid, lane, wave, true);
#endif
#if PROBE_PHASE == 7
        cross_phase(p, L, tid, lane, wave, true, 1);
#endif
#if PROBE_PHASE == 8
        cross_phase(p, L, tid, lane, wave, true, 2);
#endif
        cross_phase(p, L, tid, lane, wave); }
    SEAM(7);
    if (IN(8)) {
        pg8::Gemm g{P + G_RK, DM, (const bf16_t*)(ws + WS_WCO), MP, DM, DM}; pg8::StaticOrder S; S.init(MP, DM, G, cb);
        EpiResid<false, true> E{p.xp, p.xs, p.out, P, (float*)(ws + WS_SSQ3)}; pg8::gemm_phase<EpiResid<false, true>, true>(L, g, S, E);
        pg8::Gemm gs{P + G_RK + (size_t)MP * DM, DM, (const bf16_t*)(ws + WS_WCO), MS, DM, DM}; mini_gemm_phase<EpiResid<false, true>>(L, gs, MP, E);
    }
    SEAM(8);
    if (IN(9)) {
        pg8::Gemm g{P + G_RQ, DM, (const bf16_t*)(ws + WS_WGU), MP, 2 * DFF, DM}; pg8::StaticOrder S; S.init(MP, 2 * DFF, G, cb);
        EpiGateUp E{P, (const float*)(ws + WS_SSQ3)}; pg8::gemm_phase<EpiGateUp, true>(L, g, S, E);
        pg8::Gemm gs{P + G_RQ + (size_t)MP * DM, DM, (const bf16_t*)(ws + WS_WGU), MS, 2 * DFF, DM}; mini_gemm_phase<EpiGateUp>(L, gs, MP, E);
    }
    SEAM(9);
    if (IN(10)) {
        pg8::Gemm g{P + G_RV, DFF, (const bf16_t*)(ws + WS_WDN), MP, DM, DFF}; pg8::StaticOrder S; S.init(MP, DM, G, cb);
        EpiResid<false, false> E{p.xp, p.xs, p.out, P, (float*)(ws + WS_SSQ4)};
        if (G == 256) { EpiDownFinal EF{p.out, p.g_final, (float*)(ws + WS_XBUF), (unsigned*)(ws + WS_XCNT), L + 131072}; pg8::gemm_phase<EpiDownFinal, true>(L, g, S, EF); }
        else pg8::gemm_phase<EpiResid<false, false>, true>(L, g, S, E);
        pg8::Gemm gs{P + G_RV + (size_t)MP * DFF, DFF, (const bf16_t*)(ws + WS_WDN), MS, DM, DFF}; mini_gemm_phase<EpiResid<false, false>>(L, gs, MP, E);
    }
    SEAM(10);
    if (IN(11)) pass_final(p, lane, wave, G == 256 ? MP : 0);
#undef IN
#undef SEAM
}

#ifndef MK_SPLIT
#define MK_SPLIT 0
#endif
extern "C" void kernel_launch(void* const* d_in, const int* in_sizes, int n_in, void* d_out, int out_size, void* d_ws, size_t ws_size, hipStream_t stream) {
    static int grid = 0;
    if (grid == 0) {
        if (n_in != 26 || ws_size < WS_END3) { fprintf(stderr, "kernel_launch: unexpected problem (n_in %d, ws %zu < %zu)\n", n_in, ws_size, (size_t)WS_END); grid = -1; return; }
        int dev = 0, cus = 0, per_cu = 0;
        hipGetDevice(&dev); hipDeviceGetAttribute(&cus, hipDeviceAttributeMultiprocessorCount, dev);
        hipFuncSetAttribute((const void*)fwd_mega, hipFuncAttributeMaxDynamicSharedMemorySize, LDS_BYTES);
        hipOccupancyMaxActiveBlocksPerMultiprocessor(&per_cu, (const void*)fwd_mega, 512, LDS_BYTES);
        (void)hipGetLastError();
        if (per_cu < 1) per_cu = 1;
        grid = cus * 1;
        if (grid <= 0) grid = 256;
    }
    if (grid < 0) return;
    (void)hipMemsetAsync((unsigned char*)d_ws + WS_BAR, 0, XCD_BAR_WORDS * 4, stream);
    Params p{};
    const float** f = (const float**)&p;
    for (int i = 0; i < 26; ++i) f[i] = (const float*)d_in[i];
    p.out = (float*)d_out; p.ws = (unsigned char*)d_ws;
#if MK_SPLIT
    for (int k = 0; k < N_PHASES; ++k) { p.ph_lo = k; p.ph_hi = k + 1; hipLaunchKernelGGL(fwd_mega, dim3(grid), dim3(512), LDS_BYTES, stream, p); }
#else
    p.ph_lo = 0; p.ph_hi = N_PHASES;
    void* args[] = {&p};
    hipError_t e = hipLaunchCooperativeKernel((const void*)fwd_mega, dim3(grid), dim3(512), args, LDS_BYTES, stream);
    if (e != hipSuccess) fprintf(stderr, "cooperative launch failed: %s (grid %d)\n", hipGetErrorString(e), grid);
#endif
}
```

```cpp
#include <hip/hip_runtime.h>
#include <hip/hip_cooperative_groups.h>
#include <cstdio>
#include <cstdint>
namespace cg = cooperative_groups;

#define LAS __attribute__((address_space(3)))
#define DI __device__ __forceinline__
typedef unsigned short bf16_t;
typedef short bf16x8 __attribute__((ext_vector_type(8)));
typedef short s16x4 __attribute__((ext_vector_type(4)));
typedef float f32x4 __attribute__((ext_vector_type(4)));
typedef unsigned u32x4 __attribute__((ext_vector_type(4)));
typedef unsigned u32x2 __attribute__((ext_vector_type(2)));
typedef LAS unsigned char* lptr;
typedef _Float16 h16x2 __attribute__((ext_vector_type(2)));

constexpr int DM = 1024, SEQ = 4096, NB = 16, MP = NB * SEQ, MS = 1024, MT = MP + MS;
constexpr int DIN = 7424, DFF = 2816, NMEM = 256;
constexpr int C_RQ = 0, C_RK = 1024, C_RV = 2048, C_RG = 3072, C_SQ = 4096, C_SK = 5120, C_SV = 5248, C_GA = 5376, C_GB = 6400;
constexpr size_t GSZ = (size_t)MT * 1024, G_RQ = 0, G_RK = GSZ, G_RV = 2 * GSZ, G_RG = 3 * GSZ, G_SQ = 4 * GSZ, G_SKV = 5 * GSZ  , G_GA = G_SKV + (size_t)MT * 256, G_GB = G_GA + GSZ;
static_assert(G_GB + GSZ == (size_t)MT * DIN, "P groups");
constexpr float EPS = 1e-6f, LOG2E = 1.4426950408889634f;
constexpr size_t O_Y = 0, O_RSP = (size_t)MT * DM, O_RSS = O_RSP + 4194304, O_KP = O_RSS + 4194304, O_KS = O_KP + 262144, O_VP = O_KS + 262144,
                 O_VS = O_VP + 262144, O_MK = O_VS + 262144, O_MV = O_MK + 4194304;
constexpr size_t OB_XB = 0, OB_MB = (size_t)140 << 20;
constexpr size_t O_ROPE = O_RSP, O_RSTD1 = O_RSS, O_RSTDM = O_RSS + MT;
constexpr size_t WS_SSQR = 0, WS_SSQ2 = (size_t)MT * 16, WS_SSQ3 = WS_SSQ2 + (size_t)MT * 4, WS_SSQ4 = WS_SSQ3 + (size_t)MT * 4, WS_ZEND = WS_SSQ4 + (size_t)MT * 4;
constexpr size_t WS_WIN = (size_t)2 << 20, WS_WRO = WS_WIN + (size_t)DIN * DM * 2, WS_WSO = WS_WRO + 2097152, WS_WMX = WS_WSO + 2097152, WS_WCQ = WS_WMX + 2097152,
                 WS_WCO = WS_WCQ + 2097152, WS_WMKV = WS_WCO + 2097152, WS_WGU = WS_WMKV + 4194304, WS_WDN = WS_WGU + (size_t)2 * DFF * DM * 2, WS_WEND = WS_WDN + (size_t)DM * DFF * 2;
constexpr size_t WS_P = (size_t)48 << 20, WS_END = WS_P + (size_t)MT * DIN * 2;
static_assert(WS_ZEND <= WS_WIN && WS_WEND <= WS_P && WS_END <= ((size_t)1 << 30), "ws map");
constexpr size_t WS_XBUF = (WS_END + 255) / 256 * 256, WS_XCNT = WS_XBUF + (size_t)MP * 16, WS_END2 = WS_XCNT + 256 * 256;
constexpr size_t WS_MKVB = WS_END2, WS_CKVB = WS_MKVB + (size_t)NB * NMEM * 2048 * 2, WS_END3 = WS_CKVB + (size_t)NB * NMEM * 2048 * 2;
static_assert(WS_END3 <= ((size_t)1 << 30), "ws map 2");
constexpr int LDS_BYTES = 147456;

typedef float f32x2_t __attribute__((ext_vector_type(2)));
typedef __bf16 bf16x2_t __attribute__((ext_vector_type(2)));
DI unsigned cvt_pk_bf16(float lo, float hi) { const f32x2_t v = {lo, hi}; const bf16x2_t b = __builtin_convertvector(v, bf16x2_t); return __builtin_bit_cast(unsigned, b); }
DI float bf_lo(unsigned w) { return __uint_as_float(w << 16); }
DI float bf_hi(unsigned w) { return __uint_as_float(w & 0xffff0000u); }
DI void st8(bf16_t* p, f32x4 a, f32x4 b) { u32x4 w; w.x = cvt_pk_bf16(a.x, a.y); w.y = cvt_pk_bf16(a.z, a.w); w.z = cvt_pk_bf16(b.x, b.y); w.w = cvt_pk_bf16(b.z, b.w); *(u32x4*)p = w; }
DI void ld8(const bf16_t* p, f32x4& a, f32x4& b) { const u32x4 w = *(const u32x4*)p; a.x = bf_lo(w.x); a.y = bf_hi(w.x); a.z = bf_lo(w.y); a.w = bf_hi(w.y); b.x = bf_lo(w.z); b.y = bf_hi(w.z); b.z = bf_lo(w.w); b.w = bf_hi(w.w); }
DI float sigm(float x) { return __builtin_amdgcn_rcpf(1.f + __builtin_amdgcn_exp2f(-x * LOG2E)); }
DI f32x4 sigm4(f32x4 v) { f32x4 r; r.x = sigm(v.x); r.y = sigm(v.y); r.z = sigm(v.z); r.w = sigm(v.w); return r; }
DI float dot4(f32x4 a) { return (a.x * a.x + a.y * a.y) + (a.z * a.z + a.w * a.w); }
DI float wave_sum(float v) {
#pragma unroll
    for (int o = 1; o < 64; o <<= 1) v += __shfl_xor(v, o);
    return v;
}

namespace pg8 {
constexpr int BM = 256, BK = 64, HALF = 128, HTB = HALF * BK * 2, STAGE_BYTES = 8 * HTB, NXCD = 8, WGM = 8;
DI int lds_byte(int r, int c) { const int st = (r >> 4) * 2 + (c >> 5), rr = r & 15, cc = c & 31, ob = rr * 64 + cc * 2; return st * 1024 + (ob ^ (((ob >> 9) & 1) << 5)); }
DI void stage_rc(int b, int& R, int& C) { const int st = b / 1024, sb = b % 1024, swz = sb ^ (((sb >> 9) & 1) << 5); R = (st >> 1) * 16 + swz / 64; C = (st & 1) * 32 + (swz % 64) / 2; }
DI int perm32(int rho) { const int n = rho >> 4, i = rho & 15; return 8 * (i >> 2) + 4 * n + (i & 3); }
struct Unit { int pm, pn, r0, ui; };
struct Gemm { const bf16_t* A; int lda; const bf16_t* Bt; int M, N, K; };
struct StaticOrder {
    int nM, nN, nwg, G, c;
    DI void init(int M, int N, int G_, int c_) { nM = M / BM; nN = N / BM; nwg = nM * nN; G = G_; c = c_; }
    DI bool next(int i, Unit& u) const {
        const long L = (long)i * G + c; if (L >= nwg) return false;
        int wgid = (int)L; { const int q = nwg / NXCD, r = nwg % NXCD, xcd = wgid % NXCD, off = wgid / NXCD; wgid = (xcd < r ? xcd * (q + 1) : r * (q + 1) + (xcd - r) * q) + off; }
        const int nig = WGM * nN, gid = wgid / nig, fm = gid * WGM, gsz = (nM - fm) < WGM ? (nM - fm) : WGM;
        u.pm = fm + ((wgid % nig) % gsz); u.pn = (wgid % nig) / gsz; u.r0 = u.pm * BM; u.ui = i; return true;
    }
};
template <class Epi, bool ALIGN_EPI>
DI void gemm_phase(lptr lds, const Gemm g, const StaticOrder& S, const Epi& E) {
    const int tid = threadIdx.x, wid = __builtin_amdgcn_readfirstlane(tid >> 6), lane = tid & 63, wr = wid >> 2, wc = wid & 3, fr = lane & 15, fq = lane >> 4;
    const int K = g.K, nt = K / BK, lda = g.lda;
    unsigned voffA[2], voffB[2];
#pragma unroll
    for (int i = 0; i < 2; ++i) { int R, C; stage_rc(tid * 16 + i * 8192, R, C); const int Rb = (R & ~31) + perm32(R & 31);
        voffA[i] = (unsigned)(R * lda + C) * 2u; voffB[i] = (unsigned)(Rb * K + C) * 2u; }
    const size_t kstep = (size_t)(BK * 2);
    const size_t hstepA = (size_t)HALF * lda * 2, hstepB = (size_t)HALF * K * 2, tstepA = 2 * hstepA, tstepB = 2 * hstepB;
    const unsigned ldsw = (unsigned)wid * 1024u;
    const int aoff = lds_byte(wr * 64 + fr, fq * 8), boff = lds_byte(wc * 32 + fr, fq * 8);
#define PG8_SA(b, h) (((b) * 2 + (h)) * HTB)
#define PG8_SB(b, h) ((4 + (b) * 2 + (h)) * HTB)
#define PG8_STAGE(bufoff, gbase, voff) do { _Pragma("unroll") for (int _i = 0; _i < 2; ++_i) \
        __builtin_amdgcn_global_load_lds((const unsigned*)((const char*)(gbase) + (voff)[_i]), (LAS unsigned*)(lds + (bufoff) + ldsw + _i * 8192), 16, 0, 0); } while (0)
#define PG8_LDA(dst, b, h) do { _Pragma("unroll") for (int m = 0; m < 4; ++m) _Pragma("unroll") for (int k = 0; k < 2; ++k) dst[m][k] = *(const LAS bf16x8*)(lds + PG8_SA(b, h) + aoff + m * 2048 + k * 1024); } while (0)
#define PG8_LDB(dst, b, h) do { _Pragma("unroll") for (int n = 0; n < 2; ++n) _Pragma("unroll") for (int k = 0; k < 2; ++k) dst[n][k] = *(const LAS bf16x8*)(lds + PG8_SB(b, h) + boff + n * 2048 + k * 1024); } while (0)
#define PG8_MMA(ai, bj, At, Bt) do { __builtin_amdgcn_s_setprio(1); _Pragma("unroll") for (int m = 0; m < 4; ++m) _Pragma("unroll") for (int n = 0; n < 2; ++n) _Pragma("unroll") for (int k = 0; k < 2; ++k) \
        acc[ai][bj][m][n] = __builtin_amdgcn_mfma_f32_16x16x32_bf16(Bt[n][k], At[m][k], acc[ai][bj][m][n], 0, 0, 0); __builtin_amdgcn_s_setprio(0); } while (0)
#define PG8_WAIT_V(n) asm volatile("s_waitcnt vmcnt(" #n ")" ::: "memory")
#define PG8_WAIT_L(n) asm volatile("s_waitcnt lgkmcnt(" #n ")" ::: "memory")
#define PG8_BAR __builtin_amdgcn_s_barrier()
#define PG8_SCHED __builtin_amdgcn_sched_barrier(0)
    Unit cur, nxt; int ui = 0;
    if (!S.next(0, cur)) return;
    f32x4 acc[2][2][4][2];
#pragma unroll
    for (int a = 0; a < 2; ++a)
#pragma unroll
        for (int b = 0; b < 2; ++b)
#pragma unroll
            for (int m = 0; m < 4; ++m)
#pragma unroll
                for (int n = 0; n < 2; ++n) acc[a][b][m][n] = (f32x4){0.f, 0.f, 0.f, 0.f};
    bf16x8 At[4][2], B0[2][2], B1[2][2];
    const char* cA = (const char*)g.A + (size_t)cur.pm * tstepA; const char* cB = (const char*)g.Bt + (size_t)cur.pn * tstepB;
    if constexpr (Epi::RESCALE) E.prep(cur, tid);
    PG8_STAGE(PG8_SB(0, 0), cB, voffB); PG8_STAGE(PG8_SB(0, 1), cB + hstepB, voffB); PG8_STAGE(PG8_SA(0, 0), cA, voffA); PG8_STAGE(PG8_SA(0, 1), cA + hstepA, voffA);
    if (wr == 1) PG8_BAR;
    PG8_WAIT_V(2); PG8_BAR;
    PG8_STAGE(PG8_SB(1, 0), cB + kstep, voffB); PG8_STAGE(PG8_SA(1, 0), cA + kstep, voffA); PG8_STAGE(PG8_SB(1, 1), cB + hstepB + kstep, voffB);
    PG8_WAIT_V(6); PG8_BAR;
    for (;;) {
        const bool has_next = S.next(ui + 1, nxt);
        const char* nA = has_next ? (const char*)g.A + (size_t)nxt.pm * tstepA : cA; const char* nB = has_next ? (const char*)g.Bt + (size_t)nxt.pn * tstepB : cB;
        for (int t = 0; t < nt; t += 2) {
            const bool last = (t == nt - 2);
            if constexpr (Epi::RESCALE) { if (t == 4 || t == 8 || t == 12) E.rescale(acc, cur, t >> 2, wr, fr); }
            const char* a1 = cA + (size_t)(t + 1) * kstep;
            const char* a2 = last ? nA : cA + (size_t)(t + 2) * kstep; const char* b2 = last ? nB : cB + (size_t)(t + 2) * kstep;
            const char* a3 = a2 + kstep; const char* b3 = b2 + kstep;
            PG8_LDB(B0, 0, 0); PG8_LDB(B1, 0, 1); PG8_SCHED; PG8_LDA(At, 0, 0); PG8_STAGE(PG8_SA(1, 1), a1 + hstepA, voffA);
            PG8_WAIT_V(8); PG8_WAIT_L(0); PG8_BAR; PG8_MMA(0, 0, At, B0); PG8_MMA(0, 1, At, B1); PG8_BAR; PG8_SCHED;
            PG8_LDA(At, 0, 1); PG8_STAGE(PG8_SB(0, 0), b2, voffB); PG8_STAGE(PG8_SB(0, 1), b2 + hstepB, voffB); PG8_STAGE(PG8_SA(0, 0), a2, voffA);
            PG8_WAIT_V(8); PG8_WAIT_L(0); PG8_BAR; PG8_MMA(1, 0, At, B0); PG8_MMA(1, 1, At, B1); PG8_BAR; PG8_SCHED;
            PG8_LDB(B0, 1, 0); PG8_LDB(B1, 1, 1); PG8_SCHED; PG8_LDA(At, 1, 0); PG8_STAGE(PG8_SA(0, 1), a2 + hstepA, voffA);
            PG8_WAIT_V(8); PG8_WAIT_L(0); PG8_BAR; PG8_MMA(0, 0, At, B0); PG8_MMA(0, 1, At, B1); PG8_BAR; PG8_SCHED;
            PG8_LDA(At, 1, 1); PG8_STAGE(PG8_SB(1, 0), b3, voffB); PG8_STAGE(PG8_SB(1, 1), b3 + hstepB, voffB); PG8_STAGE(PG8_SA(1, 0), a3, voffA);
            PG8_WAIT_V(8); PG8_WAIT_L(0); PG8_BAR; PG8_MMA(1, 0, At, B0); PG8_MMA(1, 1, At, B1); PG8_BAR; PG8_SCHED;
        }
        if constexpr (ALIGN_EPI) { if (wr == 0) PG8_BAR; }
        E.template run<2>(acc, cur, wr, wc, fr, fq);
        if (!has_next) break;
#pragma unroll
        for (int a = 0; a < 2; ++a)
#pragma unroll
            for (int b = 0; b < 2; ++b)
#pragma unroll
                for (int m = 0; m < 4; ++m)
#pragma unroll
                    for (int n = 0; n < 2; ++n) acc[a][b][m][n] = (f32x4){0.f, 0.f, 0.f, 0.f};
        cur = nxt; cA = nA; cB = nB; ++ui;
        if constexpr (Epi::RESCALE) E.prep(cur, tid);
        if constexpr (ALIGN_EPI) { if (wr == 1) PG8_BAR; }
    }
    PG8_WAIT_V(0);
    if constexpr (!ALIGN_EPI) { if (wr == 0) PG8_BAR; }
    PG8_BAR;
#undef PG8_SA
#undef PG8_SB
#undef PG8_STAGE
#undef PG8_LDA
#undef PG8_LDB
#undef PG8_MMA
#undef PG8_WAIT_V
#undef PG8_WAIT_L
#undef PG8_BAR
#undef PG8_SCHED
}
}
typedef short v4i16_t __attribute__((ext_vector_type(4)));
DI bf16x8 lds16(lptr p) { return *(const LAS bf16x8*)p; }
DI s16x4 ldstr(lptr p) { return __builtin_bit_cast(s16x4, __builtin_amdgcn_ds_read_tr16_b64_v4i16((LAS v4i16_t*)p)); }
DI bf16x8 tr_pair(lptr p0, lptr p1) { const s16x4 a = ldstr(p0), b = ldstr(p1); return (bf16x8){a.x, a.y, a.z, a.w, b.x, b.y, b.z, b.w}; }
DI bf16x8 pack8(f32x4 a, f32x4 b) { u32x4 w; w.x = cvt_pk_bf16(a.x, a.y); w.y = cvt_pk_bf16(a.z, a.w); w.z = cvt_pk_bf16(b.x, b.y); w.w = cvt_pk_bf16(b.z, b.w); return __builtin_bit_cast(bf16x8, w); }
DI u32x2 pack4(f32x4 a) { u32x2 w; w.x = cvt_pk_bf16(a.x, a.y); w.y = cvt_pk_bf16(a.z, a.w); return w; }
DI f32x4 mfma16(bf16x8 a, bf16x8 b, f32x4 c) { return __builtin_amdgcn_mfma_f32_16x16x32_bf16(a, b, c, 0, 0, 0); }
DI float ex2(float x) { return __builtin_amdgcn_exp2f(x); }
DI void lds_barrier() { asm volatile("s_waitcnt lgkmcnt(0)" ::: "memory"); __builtin_amdgcn_s_barrier(); asm volatile("" ::: "memory"); }

using pg8::Unit;
#define EPI_ROW(ai, m) (u.r0 + (ai) * 128 + wr * 64 + (m) * 16 + fr)
typedef const f32x4 (&AccRef)[2][2][4][2];

DI float f16lo(unsigned w) { return (float)__builtin_bit_cast(h16x2, w).x; }
DI float f16hi(unsigned w) { return (float)__builtin_bit_cast(h16x2, w).y; }
struct EpiInProj {
    static constexpr bool RESCALE = false;
    bf16_t* P; const float* rstd; const unsigned* rope;
    template <int NAI> DI void run(AccRef acc, const Unit& u, int wr, int wc, int fr, int fq) const {
        const int pn = u.pn, cl = wc * 32 + fq * 8;
        bf16_t* const gbase = pn < 20 ? P + (size_t)(pn >> 2) * GSZ + (pn & 3) * 256 : pn == 20 ? P + G_SKV : P + G_GA + (size_t)((pn - 21) >> 2) * GSZ + ((pn - 21) & 3) * 256;
        const unsigned pitch = pn == 20 ? 256u : 1024u;
        float rsv[2][4];
#pragma unroll
        for (int ai = 0; ai < NAI; ++ai)
#pragma unroll
            for (int m = 0; m < 4; ++m) rsv[ai][m] = rstd[EPI_ROW(ai, m)];
#pragma unroll
        for (int ai = 0; ai < NAI; ++ai) {
            if (pn < 8) {
                u32x4 cs[4][2];
#pragma unroll
                for (int m = 0; m < 4; ++m) { const int row = EPI_ROW(ai, m); const int pos = row < MP ? (row & (SEQ - 1)) : (SEQ + ((row - MP) & 63));
                    const unsigned* tp = rope + pos * 128 + cl; cs[m][0] = *(const u32x4*)tp; cs[m][1] = *(const u32x4*)(tp + 4); }
#pragma unroll
                for (int m = 0; m < 4; ++m) { const int row = EPI_ROW(ai, m); bf16_t* prow = gbase + ((unsigned)row * pitch + (unsigned)cl);
                    const float sc = pn >= 4 ? rsv[ai][m] * 0.0625f : rsv[ai][m];
                    const u32x4 w0 = cs[m][0], w1 = cs[m][1];
                    const f32x4 c0 = (f32x4){f16lo(w0.x), f16lo(w0.y), f16lo(w0.z), f16lo(w0.w)}, s0 = (f32x4){f16hi(w0.x), f16hi(w0.y), f16hi(w0.z), f16hi(w0.w)};
                    const f32x4 c1 = (f32x4){f16lo(w1.x), f16lo(w1.y), f16lo(w1.z), f16lo(w1.w)}, s1 = (f32x4){f16hi(w1.x), f16hi(w1.y), f16hi(w1.z), f16hi(w1.w)};
                    const f32x4 x10 = acc[ai][0][m][0] * sc, x11 = acc[ai][0][m][1] * sc, x20 = acc[ai][1][m][0] * sc, x21 = acc[ai][1][m][1] * sc;
                    st8(prow, x10 * c0 - x20 * s0, x11 * c1 - x21 * s1);
                    st8(prow + 128, x20 * c0 + x10 * s0, x21 * c1 + x11 * s1); }
            } else {
#pragma unroll
                for (int m = 0; m < 4; ++m) { const int row = EPI_ROW(ai, m); bf16_t* prow = gbase + ((unsigned)row * pitch + (unsigned)cl); const float rs = rsv[ai][m];
#pragma unroll
                    for (int bj = 0; bj < 2; ++bj) {
                        f32x4 a = acc[ai][bj][m][0] * rs, b = acc[ai][bj][m][1] * rs;
                        if (pn >= 12 && pn < 16) { a = a * sigm4(a); b = b * sigm4(b); }
                        else if (pn >= 16 && pn < 20) { a = a * 0.125f; b = b * 0.125f; }
                        else if (pn >= 21) { a = sigm4(a); b = sigm4(b); }
                        st8(prow + bj * 128, a, b);
                    } }
            }
        }
    }
};
struct EpiMemKV {
    static constexpr bool RESCALE = false;
    float* mk; float* mv; const float* rstd; bf16_t* kvb;
    template <int NAI> DI void run(AccRef acc, const Unit& u, int wr, int wc, int fr, int fq) const {
        const int pn = u.pn, cl = wc * 32 + fq * 8; float* base = pn < 4 ? mk : mv;
        float rsv[2][4];
#pragma unroll
        for (int ai = 0; ai < NAI; ++ai)
#pragma unroll
            for (int m = 0; m < 4; ++m) rsv[ai][m] = rstd[EPI_ROW(ai, m)];
#pragma unroll
        for (int ai = 0; ai < NAI; ++ai)
#pragma unroll
            for (int m = 0; m < 4; ++m) {
                const int row = EPI_ROW(ai, m); const float rs = rsv[ai][m];
#pragma unroll
                for (int bj = 0; bj < 2; ++bj) { float* d = base + (size_t)row * DM + (pn & 3) * 256 + bj * 128 + cl;
                    const f32x4 a = acc[ai][bj][m][0] * rs, b = acc[ai][bj][m][1] * rs;
                    *(f32x4*)d = a; *(f32x4*)(d + 4) = b; st8(kvb + (size_t)row * 2048 + pn * 256 + bj * 128 + cl, a, b); }
            }
    }
};
DI void unpack8(const u32x4 w, f32x4& a, f32x4& b) { a.x = bf_lo(w.x); a.y = bf_hi(w.x); a.z = bf_lo(w.y); a.w = bf_hi(w.y); b.x = bf_lo(w.z); b.y = bf_hi(w.z); b.z = bf_lo(w.w); b.w = bf_hi(w.w); }
struct EpiSwaOut {
    static constexpr bool RESCALE = false;
    bf16_t* P;
    template <int NAI> DI void run(AccRef acc, const Unit& u, int wr, int wc, int fr, int fq) const {
        const int cl = u.pn * 256 + wc * 32 + fq * 8;
#pragma unroll
        for (int ai = 0; ai < NAI; ++ai) {
            u32x4 gv[4][2];
#pragma unroll
            for (int m = 0; m < 4; ++m)
#pragma unroll
                for (int bj = 0; bj < 2; ++bj) gv[m][bj] = *(const u32x4*)(P + G_GB + (size_t)EPI_ROW(ai, m) * 1024 + cl + bj * 128);
#pragma unroll
            for (int m = 0; m < 4; ++m)
#pragma unroll
                for (int bj = 0; bj < 2; ++bj) { f32x4 ga, gb; unpack8(gv[m][bj], ga, gb);
                    st8(P + G_GB + (size_t)EPI_ROW(ai, m) * 1024 + cl + bj * 128, acc[ai][bj][m][0] * ga, acc[ai][bj][m][1] * gb); }
        }
    }
};
struct EpiRetOut {
    static constexpr bool RESCALE = true;
    bf16_t* P; const float* ssqr; lptr tbl;
    DI f32x4 factors(int row) const { const f32x4 q = *(const f32x4*)(ssqr + (size_t)row * 4);
        const float s0 = __builtin_amdgcn_rsqf(q.x * (1.f / 256.f) + EPS), s1 = __builtin_amdgcn_rsqf(q.y * (1.f / 256.f) + EPS), s2 = __builtin_amdgcn_rsqf(q.z * (1.f / 256.f) + EPS), s3 = __builtin_amdgcn_rsqf(q.w * (1.f / 256.f) + EPS);
        return (f32x4){s0 * __builtin_amdgcn_rcpf(s1), s1 * __builtin_amdgcn_rcpf(s2), s2 * __builtin_amdgcn_rcpf(s3), s3}; }
    DI void prep(const Unit& u, int tid) const { if (tid < 256) *(LAS f32x4*)(tbl + (u.ui & 1) * 4096 + tid * 16) = factors(u.r0 + tid); }
    DI void rescale(f32x4 (&acc)[2][2][4][2], const Unit& u, int h, int wr, int fr) const {
        const LAS float* T = (const LAS float*)(tbl + (u.ui & 1) * 4096);
#pragma unroll
        for (int ai = 0; ai < 2; ++ai)
#pragma unroll
            for (int m = 0; m < 4; ++m) { const float r = T[(ai * 128 + wr * 64 + m * 16 + fr) * 4 + (h - 1)];
#pragma unroll
                for (int bj = 0; bj < 2; ++bj)
#pragma unroll
                    for (int n = 0; n < 2; ++n) acc[ai][bj][m][n] = acc[ai][bj][m][n] * r; }
    }
    template <int NAI> DI void run(AccRef acc, const Unit& u, int wr, int wc, int fr, int fq) const {
        const int cl = u.pn * 256 + wc * 32 + fq * 8;
        const LAS float* T = (const LAS float*)(tbl + (u.ui & 1) * 4096);
        float s3v[2][4];
#pragma unroll
        for (int ai = 0; ai < NAI; ++ai)
#pragma unroll
            for (int m = 0; m < 4; ++m) s3v[ai][m] = NAI == 2 ? T[(ai * 128 + wr * 64 + m * 16 + fr) * 4 + 3] : factors(EPI_ROW(ai, m)).w;
#pragma unroll
        for (int ai = 0; ai < NAI; ++ai)
#pragma unroll
        for (int mh = 0; mh < 4; mh += 2) {
            u32x4 gv[4][2], mv[4][2];
#pragma unroll
            for (int m = mh; m < mh + 2; ++m)
#pragma unroll
                for (int bj = 0; bj < 2; ++bj) { const bf16_t* g = P + G_GA + (size_t)EPI_ROW(ai, m) * 1024 + cl + bj * 128; gv[m][bj] = *(const u32x4*)g; mv[m][bj] = *(const u32x4*)(g + (G_GB - G_GA)); }
#pragma unroll
            for (int m = mh; m < mh + 2; ++m)
#pragma unroll
                for (int bj = 0; bj < 2; ++bj) { f32x4 ga, gb, ma, mb; unpack8(gv[m][bj], ga, gb); unpack8(mv[m][bj], ma, mb); const float s3 = s3v[ai][m];
                    st8(P + G_GA + (size_t)EPI_ROW(ai, m) * 1024 + cl + bj * 128, acc[ai][bj][m][0] * s3 * ga + ma, acc[ai][bj][m][1] * s3 * gb + mb); }
        }
    }
};
template <bool FROM_X, bool WRITE_HB> struct EpiResid {
    static constexpr bool RESCALE = false;
    const float* xp; const float* xs; float* H; bf16_t* P; float* ssq;
    template <int NAI> DI void run(AccRef acc, const Unit& u, int wr, int wc, int fr, int fq) const {
        const int cl = u.pn * 256 + wc * 32 + fq * 8;
#pragma unroll
        for (int ai = 0; ai < NAI; ++ai)
#pragma unroll
        for (int mh = 0; mh < 4; mh += 2) {
            f32x4 xv[4][2][2];
#pragma unroll
            for (int m = mh; m < mh + 2; ++m) { const int row = EPI_ROW(ai, m);
                const float* src = FROM_X ? (row < MP ? xp + (size_t)row * DM : xs + (size_t)(row - MP) * DM) : H + (size_t)row * DM;
#pragma unroll
                for (int bj = 0; bj < 2; ++bj) { xv[m][bj][0] = *(const f32x4*)(src + cl + bj * 128); xv[m][bj][1] = *(const f32x4*)(src + cl + bj * 128 + 4); } }
#pragma unroll
            for (int m = mh; m < mh + 2; ++m) { const int row = EPI_ROW(ai, m); float ss = 0.f;
#pragma unroll
                for (int bj = 0; bj < 2; ++bj) { const int col = cl + bj * 128;
                    const f32x4 a = xv[m][bj][0] + acc[ai][bj][m][0], b = xv[m][bj][1] + acc[ai][bj][m][1];
                    *(f32x4*)(H + (size_t)row * DM + col) = a; *(f32x4*)(H + (size_t)row * DM + col + 4) = b;
                    if (WRITE_HB) st8(P + G_RQ + (size_t)row * 1024 + col, a, b);
                    ss += dot4(a) + dot4(b); }
                ss += __shfl_xor(ss, 16); ss += __shfl_xor(ss, 32);
                if (fq == 0) unsafeAtomicAdd(ssq + row, ss); }
        }
    }
};
struct EpiCq {
    static constexpr bool RESCALE = false;
    bf16_t* P; const float* ssq;
    template <int NAI> DI void run(AccRef acc, const Unit& u, int wr, int wc, int fr, int fq) const {
        const int cl = u.pn * 256 + wc * 32 + fq * 8;
        float rsv[2][4];
#pragma unroll
        for (int ai = 0; ai < NAI; ++ai)
#pragma unroll
            for (int m = 0; m < 4; ++m) rsv[ai][m] = ssq[EPI_ROW(ai, m)];
#pragma unroll
        for (int ai = 0; ai < NAI; ++ai)
#pragma unroll
            for (int m = 0; m < 4; ++m) {
                const int row = EPI_ROW(ai, m); const float rs = 0.0625f * __builtin_amdgcn_rsqf(rsv[ai][m] * (1.f / DM) + EPS);
#pragma unroll
                for (int bj = 0; bj < 2; ++bj) st8(P + G_RK + (size_t)row * 1024 + cl + bj * 128, acc[ai][bj][m][0] * rs, acc[ai][bj][m][1] * rs);
            }
    }
};
struct EpiGateUp {
    static constexpr bool RESCALE = false;
    bf16_t* P; const float* ssq;
    template <int NAI> DI void run(AccRef acc, const Unit& u, int wr, int wc, int fr, int fq) const {
        const int cl = u.pn * 128 + wc * 32 + fq * 8;
        float rsv[2][4];
#pragma unroll
        for (int ai = 0; ai < NAI; ++ai)
#pragma unroll
            for (int m = 0; m < 4; ++m) rsv[ai][m] = ssq[EPI_ROW(ai, m)];
#pragma unroll
        for (int ai = 0; ai < NAI; ++ai)
#pragma unroll
            for (int m = 0; m < 4; ++m) {
                const int row = EPI_ROW(ai, m); const float rs = __builtin_amdgcn_rsqf(rsv[ai][m] * (1.f / DM) + EPS);
                const f32x4 g0 = acc[ai][0][m][0] * rs, g1 = acc[ai][0][m][1] * rs, u0 = acc[ai][1][m][0] * rs, u1 = acc[ai][1][m][1] * rs;
                st8(P + G_RV + (size_t)row * DFF + cl, g0 * sigm4(g0) * u0, g1 * sigm4(g1) * u1);
            }
    }
};
struct EpiDownFinal {
    static constexpr bool RESCALE = false;
    float* H; const float* gfin; float* xbuf; unsigned* cnt; lptr xl;
    template <int NAI> DI void run(AccRef acc, const Unit& u, int wr, int wc, int fr, int fq) const {
        static_assert(NAI == 2, "full units only");
        const int tid = threadIdx.x, wid = __builtin_amdgcn_readfirstlane(tid >> 6), lane = tid & 63;
        const int cl = u.pn * 256 + wc * 32 + fq * 8;
        LAS float* Pt = (LAS float*)xl; LAS float* St = (LAS float*)(xl + 4096); LAS unsigned* flag = (LAS unsigned*)(xl + 5120);
        f32x4 v[2][2][4][2];
#pragma unroll
        for (int ai = 0; ai < 2; ++ai)
#pragma unroll
            for (int m = 0; m < 4; ++m) { const int row = EPI_ROW(ai, m); float ss = 0.f;
#pragma unroll
                for (int bj = 0; bj < 2; ++bj) { const float* h = H + (size_t)row * DM + cl + bj * 128;
                    v[ai][bj][m][0] = __builtin_nontemporal_load((const f32x4*)h) + acc[ai][bj][m][0]; v[ai][bj][m][1] = __builtin_nontemporal_load((const f32x4*)(h + 4)) + acc[ai][bj][m][1];
                    ss += dot4(v[ai][bj][m][0]) + dot4(v[ai][bj][m][1]); }
                ss += __shfl_xor(ss, 16); ss += __shfl_xor(ss, 32);
                if (fq == 0) Pt[(ai * 128 + wr * 64 + m * 16 + fr) * 4 + wc] = ss; }
        lds_barrier();
        if (tid < 256) { const float tot = (Pt[tid * 4 + 0] + Pt[tid * 4 + 1]) + (Pt[tid * 4 + 2] + Pt[tid * 4 + 3]);
            __hip_atomic_store(xbuf + (size_t)(u.r0 + tid) * 4 + u.pn, tot, __ATOMIC_RELAXED, __HIP_MEMORY_SCOPE_AGENT);
            asm volatile("s_waitcnt vmcnt(0)" ::: "memory");
            if (lane == 0) __hip_atomic_fetch_add(cnt + 64 * u.pm, 1u, __ATOMIC_RELAXED, __HIP_MEMORY_SCOPE_AGENT); }
        if (wid == 0) { unsigned sp = 0;
            while ((unsigned)__builtin_amdgcn_readfirstlane(__hip_atomic_load(cnt + 64 * u.pm, __ATOMIC_RELAXED, __HIP_MEMORY_SCOPE_AGENT)) < 16u) { __builtin_amdgcn_s_sleep(2); if (++sp > (1u << 22)) break; }
            __builtin_amdgcn_fence(__ATOMIC_ACQUIRE, "agent");
            if (lane == 0) flag[0] = 1u; }
        asm volatile("s_waitcnt vmcnt(0)" ::: "memory");
        lds_barrier();
        if (tid < 256) { const float* sl = xbuf + (size_t)(u.r0 + tid) * 4; float q = 0.f;
#pragma unroll
            for (int t = 0; t < 4; ++t) q += __hip_atomic_load(sl + t, __ATOMIC_RELAXED, __HIP_MEMORY_SCOPE_AGENT);
            St[tid] = __builtin_amdgcn_rsqf(q * (1.f / DM) + EPS); }
        lds_barrier();
#pragma unroll
        for (int bj = 0; bj < 2; ++bj) { const f32x4 g0 = *(const f32x4*)(gfin + cl + bj * 128), g1 = *(const f32x4*)(gfin + cl + bj * 128 + 4);
#pragma unroll
            for (int ai = 0; ai < 2; ++ai)
#pragma unroll
                for (int m = 0; m < 4; ++m) { const int rl = ai * 128 + wr * 64 + m * 16 + fr; const float rs = St[rl]; float* o = H + (size_t)(u.r0 + rl) * DM + cl + bj * 128;
                    __builtin_nontemporal_store(v[ai][bj][m][0] * g0 * rs, (f32x4*)o); __builtin_nontemporal_store(v[ai][bj][m][1] * g1 * rs, (f32x4*)(o + 4)); } }
    }
};

template <class Epi>
DI void mini_gemm_phase(lptr L, const pg8::Gemm g, const int row_base, const Epi& E) {
    const int tid = threadIdx.x, wid = __builtin_amdgcn_readfirstlane(tid >> 6), lane = tid & 63, kh = wid >> 2, wc = wid & 3, fr = lane & 15, fq = lane >> 4;
    const int nN = g.N / 256, nItems = (g.M / 64) * nN, G = gridDim.x, nt = g.K / 64;
    constexpr int PB = 144, ST_A = 0, ST_B = 9216, ST_SZ = 46080;
    const int arow = tid >> 3, ach = tid & 7;
    for (int it = blockIdx.x; it < nItems; it += G) {
        const int im = it / nN, in = it % nN;
        const bf16_t* Ab = g.A + (size_t)(im * 64 + arow) * g.lda + ach * 8;
        const bf16_t* Bb = g.Bt + (size_t)(in * 256 + arow) * g.K + ach * 8;
        u32x4 ra[4], rb[4][4];
#pragma unroll
        for (int j = 0; j < 4; ++j) { ra[j] = *(const u32x4*)(Ab + j * 64);
#pragma unroll
            for (int k = 0; k < 4; ++k) rb[j][k] = *(const u32x4*)(Bb + (size_t)(64 * k) * g.K + j * 64); }
        f32x4 acc[2][2][4][2];
#pragma unroll
        for (int a = 0; a < 2; ++a)
#pragma unroll
            for (int b = 0; b < 2; ++b)
#pragma unroll
                for (int m = 0; m < 4; ++m)
#pragma unroll
                    for (int n = 0; n < 2; ++n) acc[a][b][m][n] = (f32x4){0.f, 0.f, 0.f, 0.f};
#pragma unroll 1
        for (int t = 0; t < nt; t += 4) {
            if constexpr (Epi::RESCALE) { if (t > 0) {
#pragma unroll
                for (int m = 0; m < 4; ++m) { const f32x4 fz = E.factors(row_base + im * 64 + 16 * m + fr); const float r = (t == 4) ? fz.x : (t == 8) ? fz.y : fz.z;
#pragma unroll
                    for (int bj = 0; bj < 2; ++bj)
#pragma unroll
                        for (int n = 0; n < 2; ++n) acc[0][bj][m][n] = acc[0][bj][m][n] * r; } } }
#pragma unroll
            for (int j = 0; j < 4; ++j) {
                lptr S = L + (j & 1) * ST_SZ;
                *(LAS u32x4*)(S + ST_A + arow * PB + ach * 16) = ra[j];
#pragma unroll
                for (int k = 0; k < 4; ++k) *(LAS u32x4*)(S + ST_B + (arow + 64 * k) * PB + ach * 16) = rb[j][k];
                lds_barrier();
                if (t + j + 4 < nt) { ra[j] = *(const u32x4*)(Ab + (t + j + 4) * 64);
#pragma unroll
                    for (int k = 0; k < 4; ++k) rb[j][k] = *(const u32x4*)(Bb + (size_t)(64 * k) * g.K + (t + j + 4) * 64); }
                bf16x8 af[4], bf[2][2];
#pragma unroll
                for (int m = 0; m < 4; ++m) af[m] = lds16(S + ST_A + (16 * m + fr) * PB + (32 * kh + 8 * fq) * 2);
#pragma unroll
                for (int bj = 0; bj < 2; ++bj)
#pragma unroll
                    for (int n = 0; n < 2; ++n) bf[bj][n] = lds16(S + ST_B + (128 * bj + 32 * wc + pg8::perm32(16 * n + fr)) * PB + (32 * kh + 8 * fq) * 2);
#pragma unroll
                for (int bj = 0; bj < 2; ++bj)
#pragma unroll
                    for (int m = 0; m < 4; ++m)
#pragma unroll
                        for (int n = 0; n < 2; ++n) acc[0][bj][m][n] = mfma16(bf[bj][n], af[m], acc[0][bj][m][n]);
            }
        }
        lds_barrier();
        if (kh == 1) {
#pragma unroll
            for (int bj = 0; bj < 2; ++bj)
#pragma unroll
                for (int m = 0; m < 4; ++m)
#pragma unroll
                    for (int n = 0; n < 2; ++n) *(LAS f32x4*)(L + ((wc * 16 + bj * 8 + m * 2 + n) * 64 + lane) * 16) = acc[0][bj][m][n];
        }
        lds_barrier();
        if (kh == 0) {
#pragma unroll
            for (int bj = 0; bj < 2; ++bj)
#pragma unroll
                for (int m = 0; m < 4; ++m)
#pragma unroll
                    for (int n = 0; n < 2; ++n) acc[0][bj][m][n] += *(const LAS f32x4*)(L + ((wc * 16 + bj * 8 + m * 2 + n) * 64 + lane) * 16);
            Unit u; u.pm = 0; u.pn = in; u.r0 = row_base + im * 64; u.ui = 0;
            E.template run<1>(acc, u, 0, wc, fr, fq);
        }
        lds_barrier();
    }
}
struct Params {
    const float *xp, *xs, *crs, *csk, *csv, *cmk, *cmv, *memp, *relb, *g_attn, *w_in, *w_ro, *w_so, *w_mx, *sinks, *g_cross, *g_mem, *w_cq, *w_mk, *w_mv, *w_co,
                *g_ffn, *w_gate, *w_up, *w_down, *g_final;
    float* out; unsigned char* ws; int ph_lo, ph_hi;
};

DI void transpose_item(const float* W, int N, const float* gain, bf16_t* WT, int ldk, int k0, int n0, int drow0, LAS float* scr, int lane) {
#pragma unroll 8
    for (int i = 0; i < 32; ++i) { const int kk = 2 * i + (lane >> 5); const float g = gain ? gain[k0 + kk] : 1.f; scr[kk * 33 + (lane & 31)] = W[(size_t)(k0 + kk) * N + n0 + (lane & 31)] * g; }
    asm volatile("s_waitcnt lgkmcnt(0)" ::: "memory");
    const int c = lane & 7;
#pragma unroll
    for (int j = 0; j < 4; ++j) { const int n = (lane >> 3) + 8 * j; const LAS float* s = scr + (8 * c) * 33 + n;
        u32x4 o; o.x = cvt_pk_bf16(s[0 * 33], s[1 * 33]); o.y = cvt_pk_bf16(s[2 * 33], s[3 * 33]); o.z = cvt_pk_bf16(s[4 * 33], s[5 * 33]); o.w = cvt_pk_bf16(s[6 * 33], s[7 * 33]);
        *(u32x4*)(WT + (size_t)(drow0 + n) * ldk + k0 + 8 * c) = o; }
    asm volatile("s_waitcnt lgkmcnt(0)" ::: "memory");
}
DI void row_to_bf16(const float* xrow, bf16_t* orow, float* rstd_out, int lane) {
    const f32x4* xr = (const f32x4*)xrow + lane; f32x4 v[4]; float s = 0.f;
#pragma unroll
    for (int j = 0; j < 4; ++j) { v[j] = xr[64 * j]; s += dot4(v[j]); }
    s = wave_sum(s);
    if (lane == 0) *rstd_out = 1.f / sqrtf(s * (1.f / DM) + EPS);
    u32x2* o8 = (u32x2*)orow + lane;
#pragma unroll
    for (int j = 0; j < 4; ++j) o8[64 * j] = pack4(v[j]);
}
DI void phase_prep(const Params& p, lptr L, int tid, int lane, int wave) {
    LAS float* scr = (LAS float*)(L + wave * 8448);
    const int G = gridDim.x, gw = blockIdx.x * 8 + wave, NGW = G * 8;
    unsigned char* ws = p.ws;
    constexpr int I_IN = 16 * 232, I_SQ = 512, I_FF = 16 * 88, I_DN = 44 * 32;
    constexpr int NITEMS = I_IN + 7 * I_SQ + 2 * I_FF + I_DN;
    for (int it = gw; it < NITEMS; it += NGW) {
        int r = it;
        if (r < I_IN) { const int kb = r / 232, nb = r % 232; transpose_item(p.w_in, DIN, p.g_attn, (bf16_t*)(ws + WS_WIN), DM, kb * 64, nb * 32, nb * 32, scr, lane); continue; } r -= I_IN;
        if (r < 7 * I_SQ) { const int mi = r / I_SQ, q = r % I_SQ, kb = q / 32, nb = q % 32;
            const float* W = mi == 0 ? p.w_ro : mi == 1 ? p.w_so : mi == 2 ? p.w_mx : mi == 3 ? p.w_cq : mi == 4 ? p.w_co : mi == 5 ? p.w_mk : p.w_mv;
            const float* gn = mi == 3 ? p.g_cross : (mi >= 5 ? p.g_mem : nullptr);
            bf16_t* WT = (bf16_t*)(ws + (mi == 0 ? WS_WRO : mi == 1 ? WS_WSO : mi == 2 ? WS_WMX : mi == 3 ? WS_WCQ : mi == 4 ? WS_WCO : WS_WMKV));
            transpose_item(W, DM, gn, WT, DM, kb * 64, nb * 32, (mi == 6 ? 1024 : 0) + nb * 32, scr, lane); continue; } r -= 7 * I_SQ;
        if (r < 2 * I_FF) { const int up = r / I_FF, q = r % I_FF, kb = q / 88, nb = q % 88, n0 = nb * 32;
            transpose_item(up ? p.w_up : p.w_gate, DFF, p.g_ffn, (bf16_t*)(ws + WS_WGU), DM, kb * 64, n0, 256 * (n0 / 128) + (n0 % 128) + up * 128, scr, lane); continue; } r -= 2 * I_FF;
        { const int kb = r / 32, nb = r % 32; transpose_item(p.w_down, DM, nullptr, (bf16_t*)(ws + WS_WDN), DFF, kb * 64, nb * 32, nb * 32, scr, lane); }
    }
    bf16_t* XB = (bf16_t*)((unsigned char*)p.out + OB_XB); bf16_t* MB = (bf16_t*)((unsigned char*)p.out + OB_MB);
    for (int m = 2 * gw; m < MT; m += 2 * NGW) {
        const float* xa = m < MP ? p.xp + (size_t)m * DM : p.xs + (size_t)(m - MP) * DM; const f32x4* xr = (const f32x4*)xa + lane; f32x4 v[8]; float s0 = 0.f, s1 = 0.f;
#pragma unroll
        for (int j = 0; j < 8; ++j) v[j] = xr[64 * j];
#pragma unroll
        for (int j = 0; j < 4; ++j) { s0 += dot4(v[j]); s1 += dot4(v[4 + j]); }
        s0 = wave_sum(s0); s1 = wave_sum(s1);
        if (lane == 0) { p.out[O_RSTD1 + m] = 1.f / sqrtf(s0 * (1.f / DM) + EPS); p.out[O_RSTD1 + m + 1] = 1.f / sqrtf(s1 * (1.f / DM) + EPS); }
        u32x2* o8 = (u32x2*)(XB + (size_t)m * DM) + lane;
#pragma unroll
        for (int j = 0; j < 8; ++j) o8[64 * j] = pack4(v[j]);
    }
    { bf16_t* CB = (bf16_t*)(ws + WS_CKVB);
      for (int m = gw; m < 2 * NB * NMEM; m += NGW) { const int r = m >> 1, isv = m & 1; const f32x4* src = (const f32x4*)((isv ? p.cmv : p.cmk) + (size_t)r * DM) + lane; u32x2* o8 = (u32x2*)(CB + (size_t)r * 2048 + isv * 1024) + lane;
#pragma unroll
          for (int j = 0; j < 4; ++j) o8[64 * j] = pack4(src[64 * j]); } }
    for (int m = gw; m < NB * NMEM; m += NGW) row_to_bf16(p.memp + (size_t)m * DM, MB + (size_t)m * DM, p.out + O_RSTDM + m, lane);
    const int gt = blockIdx.x * 512 + tid, GT = G * 512;
    for (int i = gt; i < 4160 * 128; i += GT) { const int pos = i >> 7, j = i & 127; const float inv = exp2f(-(float)j * (13.287712379549449f / 128.f)); const float ang = (float)pos * inv;
        float s, c; sincosf(ang, &s, &c); const h16x2 cs = {(_Float16)c, (_Float16)s}; ((unsigned*)(p.out + O_ROPE))[i] = __builtin_bit_cast(unsigned, cs); }
    float* z = (float*)(ws + WS_SSQR);
    for (int i = gt; i < MT * 7; i += GT) z[i] = 0.f;
    unsigned* xc = (unsigned*)(ws + WS_XCNT);
    for (int i = gt; i < 256 * 64; i += GT) xc[i] = 0u;
}

constexpr int R_QS = 0, R_KS = 33792, R_VS = 67584, R_VD = 77824, R_ST = 87040, R_END = 123904, QP = 528, VP = 144, VP2 = 160, QP2 = 544;
constexpr int L_BIAS = 124928;
DI void retention_stream(const Params& p, lptr L, int stream, int tid, int lane, int wave, const bool dry = false, const int pmode = 0) {
    const bool samp = stream >= 256; const int sid = stream & 255, b = sid >> 4, h = (sid >> 2) & 3, sl = sid & 3;
    const int nch = samp ? 1 : 64; const int rowb = samp ? MP + b * 64 : b * SEQ;
    bf16_t* P = (bf16_t*)(p.ws + WS_P); float* ssqr = (float*)(p.ws + WS_SSQR);
    const int l15 = lane & 15, g4 = lane >> 4;
    const float l2g = log2f(1.f - exp2f(-5.f - (float)h));
    const float g64 = ex2(64.f * l2g);
    const int nt = wave >> 1, mtb = 2 * (wave & 1);
    const int vrow = tid >> 3, vch = tid & 7;
    const float vdec = ex2((float)(63 - vrow) * l2g);
    u32x4 pq[4], pk[4], pv; u32x2 rgc[2];
    const bf16_t* Qb = P + G_RQ + (size_t)rowb * 1024 + h * 256; const bf16_t* Kb = Qb + GSZ;
    bf16_t* Vb = P + G_RV + (size_t)rowb * 1024 + h * 256 + sl * 64; const bf16_t* Rb = P + G_RG + (size_t)rowb * 1024 + h * 256 + sl * 64;
    const unsigned qoff = (unsigned)((tid >> 5) * 1024 + (tid & 31) * 8), voff = (unsigned)(vrow * 1024 + vch * 8), ooff = (unsigned)((16 * nt + l15) * 1024 + 16 * mtb + 4 * g4);
    auto gload = [&](int ch) {
        const unsigned c0 = (unsigned)ch * 65536u;
#pragma unroll
        for (int k = 0; k < 4; ++k) { pq[k] = *(const u32x4*)(Qb + (c0 + qoff + k * 16384u)); pk[k] = *(const u32x4*)(Kb + (c0 + qoff + k * 16384u)); }
        pv = *(const u32x4*)(Vb + (c0 + voff));
    };
    auto gload_rg = [&](int ch) {
#pragma unroll
        for (int mi = 0; mi < 2; ++mi) rgc[mi] = *(const u32x2*)(Rb + ((unsigned)ch * 65536u + ooff + 16 * mi));
    };
    gload(0); gload_rg(0);
    f32x4 accSt[4][2];
    float* sout = p.out + (samp ? O_RSS : O_RSP) + ((size_t)(b * 4 + h) * 256) * 256 + sl * 64;
    const float* sin_ = p.crs + ((size_t)(b * 4 + h) * 256) * 256 + sl * 64;
#pragma unroll
    for (int mt4 = 0; mt4 < 4; ++mt4)
#pragma unroll
        for (int ni = 0; ni < 2; ++ni) {
            const int dk = 32 * wave + 16 * ni + l15, dv = 16 * mt4 + 4 * g4;
            accSt[mt4][ni] = samp ? *(const f32x4*)(sin_ + (size_t)dk * 256 + dv) : (f32x4){0.f, 0.f, 0.f, 0.f};
            *(LAS u32x2*)(L + R_ST + dk * VP + dv * 2) = pack4(accSt[mt4][ni]);
        }
    for (int ch = 0; ch < nch; ++ch) {
#pragma unroll
        for (int k = 0; k < 4; ++k) { const int c = tid + 512 * k, row = c >> 5, cc = c & 31; *(LAS u32x4*)(L + R_QS + row * QP + cc * 16) = pq[k]; *(LAS u32x4*)(L + R_KS + row * QP + cc * 16) = pk[k]; }
        *(LAS u32x4*)(L + R_VS + vrow * VP2 + vch * 16) = pv;
        { f32x4 a, c2; a.x = bf_lo(pv.x) * vdec; a.y = bf_hi(pv.x) * vdec; a.z = bf_lo(pv.y) * vdec; a.w = bf_hi(pv.y) * vdec; c2.x = bf_lo(pv.z) * vdec; c2.y = bf_hi(pv.z) * vdec; c2.z = bf_lo(pv.w) * vdec; c2.w = bf_hi(pv.w) * vdec;
          *(LAS bf16x8*)(L + R_VD + vrow * VP + vch * 16) = pack8(a, c2); }
        lds_barrier();
        if (ch + 1 < nch) gload(ch + 1);
        if (pmode != 2) {
        bf16x8 qf[8];
#pragma unroll
        for (int ks = 0; ks < 8; ++ks) qf[ks] = lds16(L + R_QS + (16 * nt + l15) * QP + (32 * ks + 8 * g4) * 2);
        f32x4 accS[4];
#pragma unroll
        for (int jt = 0; jt < 4; ++jt) { accS[jt] = (f32x4){0.f, 0.f, 0.f, 0.f};
#pragma unroll
            for (int ks = 0; ks < 8; ++ks) accS[jt] = mfma16(lds16(L + R_KS + (16 * jt + l15) * QP + (32 * ks + 8 * g4) * 2), qf[ks], accS[jt]); }
        const int il = 16 * nt + l15;
#pragma unroll
        for (int jt = 0; jt < 4; ++jt) { const int j0 = 16 * jt + 4 * g4;
            accS[jt].x *= ex2(fabsf((float)(il - j0)) * l2g); accS[jt].y *= ex2(fabsf((float)(il - j0 - 1)) * l2g);
            accS[jt].z *= ex2(fabsf((float)(il - j0 - 2)) * l2g); accS[jt].w *= ex2(fabsf((float)(il - j0 - 3)) * l2g); }
        bf16x8 pS[2]; pS[0] = pack8(accS[0], accS[1]); pS[1] = pack8(accS[2], accS[3]);
        const float qdec = ex2((float)(il + 1) * l2g);
        const size_t orow = (size_t)(rowb + ch * 64 + il);
        float ssq = 0.f;
#pragma unroll
        for (int mi = 0; mi < 2; ++mi) { const int mt = mtb + mi; const int cb = (16 * mt + 4 * (l15 & 3)) * 2;
            f32x4 aI = (f32x4){0.f, 0.f, 0.f, 0.f}, aC = (f32x4){0.f, 0.f, 0.f, 0.f};
#pragma unroll
            for (int kk = 0; kk < 2; ++kk) { lptr v0 = L + R_VS + (32 * kk + 4 * g4 + (l15 >> 2)) * VP2 + cb; aI = mfma16(tr_pair(v0, v0 + 16 * VP2), pS[kk], aI); }
#pragma unroll
            for (int ks = 0; ks < 8; ++ks) { lptr s0 = L + R_ST + (32 * ks + 8 * g4 + (l15 >> 2)) * VP + cb; aC = mfma16(tr_pair(s0, s0 + 4 * VP), qf[ks], aC); }
            const f32x4 o = aI + aC * qdec;
            const f32x4 og = (f32x4){o.x * bf_lo(rgc[mi].x), o.y * bf_hi(rgc[mi].x), o.z * bf_lo(rgc[mi].y), o.w * bf_hi(rgc[mi].y)};
            if (!dry || o.x == 1.2345e30f) *(u32x2*)(Vb + ((unsigned)ch * 65536u + ooff + 16 * mi)) = pack4(og);
            ssq += dot4(o); }
        if (ch + 1 < nch) gload_rg(ch + 1);
        ssq += __shfl_xor(ssq, 16); ssq += __shfl_xor(ssq, 32);
        if (g4 == 0 && (!dry || ssq == 1.2345e30f)) unsafeAtomicAdd(ssqr + orow * 4 + h, ssq);
        }
        if (pmode != 1) {
#pragma unroll
        for (int mt4 = 0; mt4 < 4; ++mt4)
#pragma unroll
            for (int ni = 0; ni < 2; ++ni) accSt[mt4][ni] = accSt[mt4][ni] * g64;
#pragma unroll
        for (int kk = 0; kk < 2; ++kk) { const int r0 = 32 * kk + 8 * g4 + (l15 >> 2);
            bf16x8 bfr[2];
#pragma unroll
            for (int ni = 0; ni < 2; ++ni) { lptr k0 = L + R_KS + r0 * QP + (32 * wave + 16 * ni + 4 * (l15 & 3)) * 2; bfr[ni] = tr_pair(k0, k0 + 4 * QP); }
#pragma unroll
            for (int mt4 = 0; mt4 < 4; ++mt4) { lptr v0 = L + R_VD + r0 * VP + (16 * mt4 + 4 * (l15 & 3)) * 2; const bf16x8 afr = tr_pair(v0, v0 + 4 * VP);
#pragma unroll
                for (int ni = 0; ni < 2; ++ni) accSt[mt4][ni] = mfma16(afr, bfr[ni], accSt[mt4][ni]); } }
        }
        lds_barrier();
#pragma unroll
        for (int mt4 = 0; mt4 < 4; ++mt4)
#pragma unroll
            for (int ni = 0; ni < 2; ++ni) *(LAS u32x2*)(L + R_ST + (32 * wave + 16 * ni + l15) * VP + (16 * mt4 + 4 * g4) * 2) = pack4(accSt[mt4][ni]);
    }
#pragma unroll
    for (int mt4 = 0; mt4 < 4; ++mt4)
#pragma unroll
        for (int ni = 0; ni < 2; ++ni) if (!dry || accSt[mt4][ni].x == 1.2345e30f) *(f32x4*)(sout + (size_t)(32 * wave + 16 * ni + l15) * 256 + 16 * mt4 + 4 * g4) = accSt[mt4][ni];
}

constexpr int S_KS = 0, S_VS = 27648;
DI void swa_build_bias(const Params& p, lptr L, int tid) {
    LAS float* bl = (LAS float*)(L + L_BIAS);
    for (int i = tid; i < 16 * 256; i += 512) { const int hq = i >> 8, idx = i & 255; const int rel = idx - 191; const int n = rel < 0 ? -rel : rel;
        int large = 2 + (31 - __builtin_clz((unsigned)(n * n) | 1u)); large = large < 15 ? large : 15;
        const int bucket = (rel > 0 ? 16 : 0) + (n < 8 ? n : large);
        bl[i] = p.relb[bucket * 16 + hq]; }
}
struct SwaU { int b, n, kvh, row0; bool samp; };
DI SwaU swa_decode(int unit) { SwaU u; u.samp = unit >= 2048; if (!u.samp) { u.b = unit >> 7; u.n = (unit >> 1) & 63; } else { u.b = (unit - 2048) >> 1; u.n = 2; } u.kvh = unit & 1;
    u.row0 = u.samp ? MP + u.b * 64 : u.b * SEQ + u.n * 64; return u; }
DI void swa_gload(const Params& p, const SwaU& u, int tid, u32x4 (&kr)[3], u32x4 (&vr)[3]) {
    const bf16_t* P = (const bf16_t*)(p.ws + WS_P);
#pragma unroll
    for (int k = 0; k < 3; ++k) { const int c = tid + 512 * k, row = c >> 3, cc = c & 7; kr[k] = (u32x4){0u, 0u, 0u, 0u}; vr[k] = kr[k];
        if (u.n * 64 - 128 + row >= 0) { const bf16_t* src = P + G_SKV + (size_t)(u.row0 - 128 + row) * 256 + u.kvh * 64 + cc * 8; kr[k] = *(const u32x4*)src; vr[k] = *(const u32x4*)(src + 128); } }
}
DI void swa_stage_sample(const Params& p, lptr L, const SwaU& u, int tid) {
    const bf16_t* P = (const bf16_t*)(p.ws + WS_P);
#pragma unroll 1
    for (int k = 0; k < 3; ++k) { const int c = tid + 512 * k, row = c >> 3, cc = c & 7; u32x4 kv, vv;
        if (row < 128) { const size_t o = ((size_t)(u.b * 128 + row) * 2 + u.kvh) * 64 + cc * 8;
            kv = __builtin_bit_cast(u32x4, pack8(*(const f32x4*)(p.csk + o), *(const f32x4*)(p.csk + o + 4))); vv = __builtin_bit_cast(u32x4, pack8(*(const f32x4*)(p.csv + o), *(const f32x4*)(p.csv + o + 4))); }
        else { const bf16_t* src = P + G_SKV + (size_t)(u.row0 - 128 + row) * 256 + u.kvh * 64 + cc * 8; kv = *(const u32x4*)src; vv = *(const u32x4*)(src + 128); }
        *(LAS u32x4*)(L + S_KS + row * VP + cc * 16) = kv; *(LAS u32x4*)(L + S_VS + row * VP2 + cc * 16) = vv; }
}
DI void swa_phase(const Params& p, lptr L, int tid, int lane, int wave, const bool dry = false) {
    bf16_t* P = (bf16_t*)(p.ws + WS_P);
    const int G = gridDim.x, NU = 2048 + 32; const int l15 = lane & 15, g4 = lane >> 4;
    int unit = blockIdx.x; if (unit >= NU) return;
    u32x4 kr[3], vr[3];
    SwaU u = swa_decode(unit);
    for (; unit < NU; unit += G) {
        u = swa_decode(unit);
        const int hq = u.kvh * 8 + wave; const float sink = p.sinks[hq];
        bf16_t* qbase = P + G_SQ + (size_t)(u.row0 + l15) * 1024 + hq * 64;
        bf16x8 qn0 = *(const bf16x8*)(qbase + 8 * g4), qn1 = *(const bf16x8*)(qbase + 32 + 8 * g4);
        lds_barrier();
        if (u.samp) swa_stage_sample(p, L, u, tid);
        else { swa_gload(p, u, tid, kr, vr);
#pragma unroll
            for (int k = 0; k < 3; ++k) { const int c = tid + 512 * k, row = c >> 3, cc = c & 7; *(LAS u32x4*)(L + S_KS + row * VP + cc * 16) = kr[k]; *(LAS u32x4*)(L + S_VS + row * VP2 + cc * 16) = vr[k]; } }
        lds_barrier();
        const LAS float* bl = (const LAS float*)(L + L_BIAS) + hq * 256;
        const int kmin = 128 - u.n * 64;
#pragma unroll 1
        for (int qb = 0; qb < 4; ++qb) {
            const int iq = qb * 16 + l15; bf16_t* qp = qbase + (size_t)qb * 16 * 1024;
            const bf16x8 q0 = qn0, q1 = qn1;
            if (qb < 3) { qn0 = *(const bf16x8*)(qp + (size_t)16 * 1024 + 8 * g4); qn1 = *(const bf16x8*)(qp + (size_t)16 * 1024 + 32 + 8 * g4); }
            f32x4 s[12]; float mx = -3.0e38f;
#pragma unroll
            for (int tg = 0; tg < 12; tg += 4) {
                bf16x8 kf[4][2]; f32x4 bb[4];
#pragma unroll
                for (int t4 = 0; t4 < 4; ++t4) { const int t = tg + t4;
                    kf[t4][0] = lds16(L + S_KS + (16 * t + l15) * VP + (8 * g4) * 2); kf[t4][1] = lds16(L + S_KS + (16 * t + l15) * VP + (32 + 8 * g4) * 2);
                    const int bi = 16 * t + 4 * g4 + 63 - iq; bb[t4] = (f32x4){bl[bi], bl[bi + 1], bl[bi + 2], bl[bi + 3]}; }
                __builtin_amdgcn_sched_barrier(0);
#pragma unroll
                for (int t4 = 0; t4 < 4; ++t4) { const int t = tg + t4;
                    s[t] = mfma16(kf[t4][0], q0, (f32x4){0.f, 0.f, 0.f, 0.f}); s[t] = mfma16(kf[t4][1], q1, s[t]); }
#pragma unroll
                for (int t4 = 0; t4 < 4; ++t4) { const int t = tg + t4; const int key = 16 * t + 4 * g4;
                    s[t] = s[t] + bb[t4];
                    if (kmin > 0) { if (key < kmin) s[t].x = -1e30f; if (key + 1 < kmin) s[t].y = -1e30f; if (key + 2 < kmin) s[t].z = -1e30f; if (key + 3 < kmin) s[t].w = -1e30f; }
                    mx = fmaxf(mx, fmaxf(fmaxf(s[t].x, s[t].y), fmaxf(s[t].z, s[t].w))); }
                __builtin_amdgcn_sched_barrier(0);
            }
            mx = fmaxf(mx, __shfl_xor(mx, 16)); mx = fmaxf(mx, __shfl_xor(mx, 32)); mx = fmaxf(mx, sink);
            float sum = 0.f; const float mb = mx * LOG2E;
#pragma unroll
            for (int t = 0; t < 12; ++t) { s[t].x = ex2(s[t].x * LOG2E - mb); s[t].y = ex2(s[t].y * LOG2E - mb); s[t].z = ex2(s[t].z * LOG2E - mb); s[t].w = ex2(s[t].w * LOG2E - mb);
                sum += (s[t].x + s[t].y) + (s[t].z + s[t].w); }
            sum += __shfl_xor(sum, 16); sum += __shfl_xor(sum, 32);
            const float inv = 1.f / (sum + ex2(sink * LOG2E - mb));
            f32x4 o[4];
#pragma unroll
            for (int mt = 0; mt < 4; ++mt) o[mt] = (f32x4){0.f, 0.f, 0.f, 0.f};
#pragma unroll
            for (int kk = 0; kk < 6; ++kk) { const bf16x8 pf = pack8(s[2 * kk] * inv, s[2 * kk + 1] * inv);
#pragma unroll
                for (int mt = 0; mt < 4; ++mt) { lptr v0 = L + S_VS + (32 * kk + 4 * g4 + (l15 >> 2)) * VP2 + (16 * mt + 4 * (l15 & 3)) * 2; o[mt] = mfma16(tr_pair(v0, v0 + 16 * VP2), pf, o[mt]); }
                if (kk & 1) __builtin_amdgcn_sched_barrier(0); }
#pragma unroll
            for (int mt = 0; mt < 4; ++mt) if (!dry || o[mt].x == 1.2345e30f) *(u32x2*)(qp + 16 * mt + 4 * g4) = pack4(o[mt]);
        }
    }
    __syncthreads();
}

DI int cross_unit_of(int item, int c, int G) { if (G != 256) return item * G + c; if (item < 8) return ((8 * item + (c & 7)) << 5) + (c >> 3); return (item == 8 && c < 64) ? 2048 + c : -1; }
struct CrU { int b, hh, row0, nq; const bf16_t* Kg; const bf16_t* Vg; };
DI CrU cross_decode(const Params& p, int unit) { CrU u; const bool samp = unit >= 2048;
    if (!samp) { u.b = unit >> 7; u.hh = (unit >> 5) & 3; u.row0 = u.b * SEQ + (unit & 31) * 128; u.nq = 128; } else { const int u2 = unit - 2048; u.b = u2 >> 2; u.hh = u2 & 3; u.row0 = MP + u.b * 64; u.nq = 64; }
    u.Kg = (const bf16_t*)(p.ws + (samp ? WS_CKVB : WS_MKVB)) + (size_t)u.b * 256 * 2048 + u.hh * 256; u.Vg = u.Kg + 1024; return u; }
constexpr int CR_BUF = 34816;
DI const bf16_t* cross_blk(const CrU& u, int j) { return (j < 4 ? u.Kg : u.Vg) + (size_t)((j & 3) * 64) * 2048; }
DI void cross_gload(const bf16_t* src, int tid, u32x4 (&r)[4]) {
#pragma unroll
    for (int k = 0; k < 4; ++k) { const int c = tid + 512 * k, row = c >> 5, cc = c & 31; r[k] = *(const u32x4*)(src + (size_t)row * 2048 + cc * 8); }
}
DI void cross_swrite(lptr B, int tid, const u32x4 (&r)[4], const int pitch) {
#pragma unroll
    for (int k = 0; k < 4; ++k) { const int c = tid + 512 * k, row = c >> 5, cc = c & 31; *(LAS u32x4*)(B + row * pitch + cc * 16) = r[k]; }
}
DI void cross_phase(const Params& p, lptr L, int tid, int lane, int wave, const bool dry = false, const int pmode = 0) {
    bf16_t* P = (bf16_t*)(p.ws + WS_P);
    const int G = gridDim.x, NU = 2048 + 64, cbk = blockIdx.x; const int l15 = lane & 15, g4 = lane >> 4;
    int item = 0, unit = cross_unit_of(0, cbk, G); if (unit < 0 || unit >= NU) return;
    u32x4 pre[4];
    CrU u = cross_decode(p, unit);
    cross_gload(cross_blk(u, 0), tid, pre); cross_swrite(L, tid, pre, QP);
    cross_gload(cross_blk(u, 1), tid, pre);
    for (;;) {
        const int unext = cross_unit_of(item + 1, cbk, G); const bool has_next = unext >= 0 && unext < NU;
        CrU un = u; if (has_next) un = cross_decode(p, unext);
        const bool active = wave * 16 < u.nq && pmode != 1;
        bf16_t* qp = P + G_RK + (size_t)(u.row0 + (wave * 16 < u.nq ? wave * 16 + l15 : 0)) * 1024 + u.hh * 256;
        bf16x8 qf[8];
#pragma unroll
        for (int ks = 0; ks < 8; ++ks) qf[ks] = *(const bf16x8*)(qp + 32 * ks + 8 * g4);
        f32x4 s[16];
#pragma unroll
        for (int t = 0; t < 16; ++t) s[t] = (f32x4){0.f, 0.f, 0.f, 0.f};
        bf16x8 pf[8];
        f32x4 o[16];
#pragma unroll
        for (int i = 0; i < 8; ++i) {
            lds_barrier();
            lptr cur = L + (i & 1) * CR_BUF, oth = L + ((i + 1) & 1) * CR_BUF;
            if (pmode != 2) {
                if (i < 7 || has_next) cross_swrite(oth, tid, pre, (i + 1) & 4 ? QP2 : QP);
                if (i < 6) cross_gload(cross_blk(u, i + 2), tid, pre); else if (has_next) cross_gload(cross_blk(un, i - 6), tid, pre);
            }
            if (i < 4) {
                if (active) {
#pragma unroll
                    for (int t = 0; t < 4; ++t)
#pragma unroll
                        for (int ks = 0; ks < 8; ++ks) s[i * 4 + t] = mfma16(lds16(cur + (16 * t + l15) * QP + (32 * ks + 8 * g4) * 2), qf[ks], s[i * 4 + t]);
                }
                if (i == 3) {
                    float mx = -3.0e38f;
#pragma unroll
                    for (int t = 0; t < 16; ++t) mx = fmaxf(mx, fmaxf(fmaxf(s[t].x, s[t].y), fmaxf(s[t].z, s[t].w)));
                    mx = fmaxf(mx, __shfl_xor(mx, 16)); mx = fmaxf(mx, __shfl_xor(mx, 32));
                    float sum = 0.f; const float mb = mx * LOG2E;
#pragma unroll
                    for (int t = 0; t < 16; ++t) { s[t].x = ex2(s[t].x * LOG2E - mb); s[t].y = ex2(s[t].y * LOG2E - mb); s[t].z = ex2(s[t].z * LOG2E - mb); s[t].w = ex2(s[t].w * LOG2E - mb);
                        sum += (s[t].x + s[t].y) + (s[t].z + s[t].w); }
                    sum += __shfl_xor(sum, 16); sum += __shfl_xor(sum, 32);
                    const float inv = 1.f / sum;
#pragma unroll
                    for (int kk = 0; kk < 8; ++kk) pf[kk] = pack8(s[2 * kk] * inv, s[2 * kk + 1] * inv);
#pragma unroll
                    for (int mt = 0; mt < 16; ++mt) o[mt] = (f32x4){0.f, 0.f, 0.f, 0.f};
                }
            } else {
                const int vb = i - 4;
                if (active) {
#pragma unroll
                    for (int k2 = 0; k2 < 2; ++k2)
#pragma unroll
                        for (int mt = 0; mt < 16; ++mt) { lptr v0 = cur + (32 * k2 + 4 * g4 + (l15 >> 2)) * QP2 + (16 * mt + 4 * (l15 & 3)) * 2; o[mt] = mfma16(tr_pair(v0, v0 + 16 * QP2), pf[2 * vb + k2], o[mt]); }
                }
            }
        }
        if (active) {
#pragma unroll
            for (int mt = 0; mt < 16; ++mt) if (!dry || o[mt].x == 1.2345e30f) *(u32x2*)(qp + 16 * mt + 4 * g4) = pack4(o[mt]);
        }
        if (!has_next) break;
        unit = unext; ++item; u = un;
    }
    __syncthreads();
}
DI void pass_final(const Params& p, int lane, int wave, const int row_lo) {
    const float* ssq = (const float*)(p.ws + WS_SSQ4);
    const int gw = blockIdx.x * 8 + wave, NGW = gridDim.x * 8;
    f32x4 g[4];
#pragma unroll
    for (int j = 0; j < 4; ++j) g[j] = *((const f32x4*)p.g_final + lane + 64 * j);
    for (int m = row_lo + gw; m < MT; m += NGW) { const float rs = 1.f / sqrtf(ssq[m] * (1.f / DM) + EPS); f32x4* h = (f32x4*)(p.out + (size_t)m * DM) + lane;
#pragma unroll
        for (int j = 0; j < 4; ++j) h[64 * j] = h[64 * j] * g[j] * rs; }
}
DI void pass_swa_cache_out(const Params& p, int tid) {
    const bf16_t* P = (const bf16_t*)(p.ws + WS_P);
    const int gt = blockIdx.x * 512 + tid, GT = gridDim.x * 512;
    for (int i = gt; i < 4 * 262144; i += GT) { const int which = i >> 18, r = i & 262143, b = r >> 14, j = (r >> 7) & 127, c = r & 127;
        const bool isv = which >= 2, samp = which & 1; float v;
        if (!samp) v = bf_lo((unsigned)P[G_SKV + (size_t)(b * SEQ + SEQ - 128 + j) * 256 + (isv ? 128 : 0) + c]);
        else if (j < 64) v = (isv ? p.csv : p.csk)[(size_t)(b * 128 + 64 + j) * 128 + c];
        else v = bf_lo((unsigned)P[G_SKV + (size_t)(MP + b * 64 + j - 64) * 256 + (isv ? 128 : 0) + c]);
        p.out[(which == 0 ? O_KP : which == 1 ? O_KS : which == 2 ? O_VP : O_VS) + r] = v; }
}


#define XB_TMO      128
#define XB_XCNT(j)  (256  + 64 * (j))
#define XB_XSUB(j)  (1280 + 64 * (j))
#define XB_XGEN(j)  (2304 + 64 * (j))
#define XB_TOP      3328
#define XB_TOPGEN   3392
#define XCD_BAR_WORDS 3456
#define XB_SPIN_CAP (1u << 18)
constexpr size_t WS_BAR = 1900544;
static_assert(WS_BAR >= WS_ZEND && WS_BAR + XCD_BAR_WORDS * 4 <= WS_WIN && WS_BAR % 256 == 0, "barrier words");
constexpr int L_MISC = 141312;
DI unsigned xb_ld(unsigned* p)              { return __hip_atomic_load(p, __ATOMIC_RELAXED, __HIP_MEMORY_SCOPE_AGENT); }
DI unsigned xb_add(unsigned* p, unsigned v) { return __hip_atomic_fetch_add(p, v, __ATOMIC_RELAXED, __HIP_MEMORY_SCOPE_AGENT); }
DI unsigned xb_xcc_id() { return (unsigned)__builtin_amdgcn_s_getreg((3 << 11) | 20) & 0xFu; }
#define XB_SPIN(cond, bar) do { unsigned _sp = 0; while (cond) { __builtin_amdgcn_s_sleep(1); \
    if ((++_sp & 255u) == 0u) { if (xb_ld(&(bar)[XB_TMO])) break; if (_sp > XB_SPIN_CAP) { atomicAdd(&(bar)[XB_TMO], 1u); break; } } } } while (0)
struct XcdBarrier { unsigned* bar; unsigned x; volatile LAS unsigned* st; };
DI XcdBarrier xcd_barrier_post(unsigned* bar, volatile LAS unsigned* st) {
    XcdBarrier b; b.bar = bar; b.x = xb_xcc_id(); b.st = st;
    if (threadIdx.x == 0) (void)xb_add(&bar[XB_XCNT(b.x)], 1u);
    return b;
}
DI void xcd_barrier_complete(unsigned* bar, unsigned x, unsigned& nloc, unsigned& nx) {
    const unsigned G = gridDim.x * gridDim.y * gridDim.z;
    unsigned sum, cnt, mine, sp = 0u;
    for (;;) {
        sum = 0u; cnt = 0u; mine = 0u;
#pragma unroll
        for (unsigned j = 0; j < 16; ++j) { const unsigned c = xb_ld(&bar[XB_XCNT(j)]); sum += c; cnt += (c > 0u) ? 1u : 0u; mine = (j == x) ? c : mine; }
        if (sum == G) break;
        __builtin_amdgcn_s_sleep(1);
        if ((++sp & 255u) == 0u) { if (xb_ld(&bar[XB_TMO])) break; if (sp > XB_SPIN_CAP) { atomicAdd(&bar[XB_TMO], 1u); break; } }
    }
    nloc = mine > 0u ? mine : 1u; nx = cnt > 0u ? cnt : 1u;
}
DI void xcd_barrier(const XcdBarrier& b) {
    asm volatile("s_waitcnt vmcnt(0)" ::: "memory");
    __syncthreads();
    if (threadIdx.x == 0) {
        unsigned* bar = b.bar;
        __builtin_amdgcn_s_waitcnt(0);
        unsigned nloc = b.st[0], nx = b.st[1];
        if (nloc == 0u) { xcd_barrier_complete(bar, b.x, nloc, nx); b.st[0] = nloc; b.st[1] = nx; }
        const unsigned old = xb_add(&bar[XB_XSUB(b.x)], 1u);
        const unsigned gen = old / nloc;
        if (old + 1u == (gen + 1u) * nloc) {
            __builtin_amdgcn_fence(__ATOMIC_RELEASE, "agent");
            asm volatile("s_waitcnt vmcnt(0)" ::: "memory");
            const unsigned og = xb_add(&bar[XB_TOP], 1u);
            const unsigned tg = og / nx;
            if (og + 1u == (tg + 1u) * nx) xb_add(&bar[XB_TOPGEN], 1u);
            else XB_SPIN(xb_ld(&bar[XB_TOPGEN]) == tg, bar);
            __builtin_amdgcn_fence(__ATOMIC_ACQUIRE, "agent");
            xb_add(&bar[XB_XGEN(b.x)], 1u);
            asm volatile("s_waitcnt vmcnt(0)" ::: "memory");
        } else {
            XB_SPIN(xb_ld(&bar[XB_XGEN(b.x)]) == gen, bar);
            __builtin_amdgcn_fence(__ATOMIC_ACQUIRE, "agent");
            asm volatile("s_waitcnt vmcnt(0)" ::: "memory");
        }
    }
    __syncthreads();
}

constexpr int N_PHASES = 12;
#ifndef PROBE_PHASE
#define PROBE_PHASE 0
#endif
__global__ void __launch_bounds__(512, 2) fwd_mega(Params p) {
    extern __shared__ __attribute__((aligned(16))) unsigned char lds_raw[];
    lptr L = (lptr)lds_raw;
    const int tid = threadIdx.x, lane = tid & 63, wave = __builtin_amdgcn_readfirstlane(tid >> 6);
    const int G = gridDim.x, cb = blockIdx.x;
    unsigned char* ws = p.ws; bf16_t* P = (bf16_t*)(ws + WS_P);
    const int lo = p.ph_lo, hi = p.ph_hi;
#define IN(k) (lo <= (k) && (k) < hi)
    if (tid < 2) ((volatile LAS unsigned*)(L + L_MISC))[tid] = 0u;
    __syncthreads();
    const XcdBarrier xbar = xcd_barrier_post((unsigned*)(ws + WS_BAR), (volatile LAS unsigned*)(L + L_MISC));
#define SEAM(k) do { if (IN(k) && IN((k) + 1)) xcd_barrier(xbar); } while (0)
    if (lo < 0) cg::this_grid().sync();
#if PROBE_PHASE == 5
    for (int i = 0; i < 10; ++i) cg::this_grid().sync();
#endif
#if PROBE_PHASE == 6
    phase_prep(p, L, tid, lane, wave);
#endif
    if (IN(0)) { phase_prep(p, L, tid, lane, wave); }
    SEAM(0);
    if (IN(1)) {
#if PROBE_PHASE == 4
        { pg8::Gemm g{(const bf16_t*)((unsigned char*)p.out + OB_XB), DM, (const bf16_t*)(ws + WS_WIN), MT, DIN, DM}; pg8::StaticOrder S; S.init(MT, DIN, G, cb);
          EpiInProj E{P, p.out + O_RSTD1, (const unsigned*)(p.out + O_ROPE)}; pg8::gemm_phase<EpiInProj, true>(L, g, S, E); }
#endif
        { pg8::Gemm g{(const bf16_t*)((unsigned char*)p.out + OB_XB), DM, (const bf16_t*)(ws + WS_WIN), MT, DIN, DM}; pg8::StaticOrder S; S.init(MT, DIN, G, cb);
          EpiInProj E{P, p.out + O_RSTD1, (const unsigned*)(p.out + O_ROPE)}; pg8::gemm_phase<EpiInProj, true>(L, g, S, E); }
        { const int r = ((MT / 256) * (DIN / 256)) % G; const int c2 = (cb - r + G) % G;
          pg8::Gemm g{(const bf16_t*)((unsigned char*)p.out + OB_MB), DM, (const bf16_t*)(ws + WS_WMKV), NB * NMEM, 2048, DM}; pg8::StaticOrder S; S.init(NB * NMEM, 2048, G, c2);
          EpiMemKV E{p.out + O_MK, p.out + O_MV, p.out + O_RSTDM, (bf16_t*)(ws + WS_MKVB)}; pg8::gemm_phase<EpiMemKV, true>(L, g, S, E); }
    }
    SEAM(1);
    if (IN(2)) {
        swa_build_bias(p, L, tid);
        pass_swa_cache_out(p, tid);
#if PROBE_PHASE == 1
        for (int s = cb; s < 512; s += G) retention_stream(p, L, s, tid, lane, wave, true);
        __syncthreads();
#endif
#if PROBE_PHASE == 10
        for (int s = cb; s < 512; s += G) retention_stream(p, L, s, tid, lane, wave, true, 1);
        __syncthreads();
#endif
#if PROBE_PHASE == 11
        for (int s = cb; s < 512; s += G) retention_stream(p, L, s, tid, lane, wave, true, 2);
        __syncthreads();
#endif
#if PROBE_PHASE == 2
        swa_phase(p, L, tid, lane, wave, true);
#endif
        for (int s = cb; s < 512; s += G) { int st = s; if (G == 256) { const int c = s & 255; st = (s & 256) | ((((c & 7) + 8 * (c >> 5)) << 2) | ((c >> 3) & 3)); }
            retention_stream(p, L, st, tid, lane, wave); }
        __syncthreads();
        swa_phase(p, L, tid, lane, wave);
    }
    SEAM(2);
    if (IN(3)) {
        pg8::Gemm g{P + G_SQ, DM, (const bf16_t*)(ws + WS_WSO), MP, DM, DM}; pg8::StaticOrder S; S.init(MP, DM, G, cb);
        EpiSwaOut E{P}; pg8::gemm_phase<EpiSwaOut, true>(L, g, S, E);
        pg8::Gemm gs{P + G_SQ + (size_t)MP * DM, DM, (const bf16_t*)(ws + WS_WSO), MS, DM, DM}; mini_gemm_phase<EpiSwaOut>(L, gs, MP, E);
        {
        pg8::Gemm g{P + G_RV, DM, (const bf16_t*)(ws + WS_WRO), MP, DM, DM}; pg8::StaticOrder S; S.init(MP, DM, G, cb);
        EpiRetOut E{P, (const float*)(ws + WS_SSQR), L + 131072}; pg8::gemm_phase<EpiRetOut, true>(L, g, S, E);
        pg8::Gemm gs{P + G_RV + (size_t)MP * DM, DM, (const bf16_t*)(ws + WS_WRO), MS, DM, DM}; mini_gemm_phase<EpiRetOut>(L, gs, MP, E);
        }
    }
    SEAM(3);
    if (IN(5)) {
        pg8::Gemm g{P + G_GA, DM, (const bf16_t*)(ws + WS_WMX), MP, DM, DM}; pg8::StaticOrder S; S.init(MP, DM, G, cb);
        EpiResid<true, true> E{p.xp, p.xs, p.out, P, (float*)(ws + WS_SSQ2)}; pg8::gemm_phase<EpiResid<true, true>, true>(L, g, S, E);
        pg8::Gemm gs{P + G_GA + (size_t)MP * DM, DM, (const bf16_t*)(ws + WS_WMX), MS, DM, DM}; mini_gemm_phase<EpiResid<true, true>>(L, gs, MP, E);
    }
    SEAM(5);
    if (IN(6)) {
#if PROBE_PHASE == 9
        { pg8::Gemm g{P + G_RQ, DM, (const bf16_t*)(ws + WS_WCQ), MP, DM, DM}; pg8::StaticOrder S; S.init(MP, DM, G, cb);
          EpiCq E{P, (const float*)(ws + WS_SSQ2)}; pg8::gemm_phase<EpiCq, true>(L, g, S, E); }
#endif
        pg8::Gemm g{P + G_RQ, DM, (const bf16_t*)(ws + WS_WCQ), MP, DM, DM}; pg8::StaticOrder S; S.init(MP, DM, G, cb);
        EpiCq E{P, (const float*)(ws + WS_SSQ2)}; pg8::gemm_phase<EpiCq, true>(L, g, S, E);
        pg8::Gemm gs{P + G_RQ + (size_t)MP * DM, DM, (const bf16_t*)(ws + WS_WCQ), MS, DM, DM}; mini_gemm_phase<EpiCq>(L, gs, MP, E);
    }
    SEAM(6);
    if (IN(7)) {
#if PROBE_PHASE == 3
        cross_phase(p, L, tid, lane, wave, true);
#endif
#if PROBE_PHASE == 7
        cross_phase(p, L, tid, lane, wave, true, 1);
#endif
#if PROBE_PHASE == 8
        cross_phase(p, L, tid, lane, wave, true, 2);
#endif
        cross_phase(p, L, tid, lane, wave); }
    SEAM(7);
    if (IN(8)) {
        pg8::Gemm g{P + G_RK, DM, (const bf16_t*)(ws + WS_WCO), MP, DM, DM}; pg8::StaticOrder S; S.init(MP, DM, G, cb);
        EpiResid<false, true> E{p.xp, p.xs, p.out, P, (float*)(ws + WS_SSQ3)}; pg8::gemm_phase<EpiResid<false, true>, true>(L, g, S, E);
        pg8::Gemm gs{P + G_RK + (size_t)MP * DM, DM, (const bf16_t*)(ws + WS_WCO), MS, DM, DM}; mini_gemm_phase<EpiResid<false, true>>(L, gs, MP, E);
    }
    SEAM(8);
    if (IN(9)) {
        pg8::Gemm g{P + G_RQ, DM, (const bf16_t*)(ws + WS_WGU), MP, 2 * DFF, DM}; pg8::StaticOrder S; S.init(MP, 2 * DFF, G, cb);
        EpiGateUp E{P, (const float*)(ws + WS_SSQ3)}; pg8::gemm_phase<EpiGateUp, true>(L, g, S, E);
        pg8::Gemm gs{P + G_RQ + (size_t)MP * DM, DM, (const bf16_t*)(ws + WS_WGU), MS, 2 * DFF, DM}; mini_gemm_phase<EpiGateUp>(L, gs, MP, E);
    }
    SEAM(9);
    if (IN(10)) {
        pg8::Gemm g{P + G_RV, DFF, (const bf16_t*)(ws + WS_WDN), MP, DM, DFF}; pg8::StaticOrder S; S.init(MP, DM, G, cb);
        EpiResid<false, false> E{p.xp, p.xs, p.out, P, (float*)(ws + WS_SSQ4)};
        if (G == 256) { EpiDownFinal EF{p.out, p.g_final, (float*)(ws + WS_XBUF), (unsigned*)(ws + WS_XCNT), L + 131072}; pg8::gemm_phase<EpiDownFinal, true>(L, g, S, EF); }
        else pg8::gemm_phase<EpiResid<false, false>, true>(L, g, S, E);
        pg8::Gemm gs{P + G_RV + (size_t)MP * DFF, DFF, (const bf16_t*)(ws + WS_WDN), MS, DM, DFF}; mini_gemm_phase<EpiResid<false, false>>(L, gs, MP, E);
    }
    SEAM(10);
    if (IN(11)) pass_final(p, lane, wave, G == 256 ? MP : 0);
#undef IN
#undef SEAM
}

#ifndef MK_SPLIT
#define MK_SPLIT 0
#endif
extern "C" void kernel_launch(void* const* d_in, const int* in_sizes, int n_in, void* d_out, int out_size, void* d_ws, size_t ws_size, hipStream_t stream) {
    static int grid = 0;
    if (grid == 0) {
        if (n_in != 26 || ws_size < WS_END3) { fprintf(stderr, "kernel_launch: unexpected problem (n_in %d, ws %zu < %zu)\n", n_in, ws_size, (size_t)WS_END); grid = -1; return; }
        int dev = 0, cus = 0, per_cu = 0;
        hipGetDevice(&dev); hipDeviceGetAttribute(&cus, hipDeviceAttributeMultiprocessorCount, dev);
        hipFuncSetAttribute((const void*)fwd_mega, hipFuncAttributeMaxDynamicSharedMemorySize, LDS_BYTES);
        hipOccupancyMaxActiveBlocksPerMultiprocessor(&per_cu, (const void*)fwd_mega, 512, LDS_BYTES);
        (void)hipGetLastError();
        if (per_cu < 1) per_cu = 1;
        grid = cus * 1;
        if (grid <= 0) grid = 256;
    }
    if (grid < 0) return;
    (void)hipMemsetAsync((unsigned char*)d_ws + WS_BAR, 0, XCD_BAR_WORDS * 4, stream);
    Params p{};
    const float** f = (const float**)&p;
    for (int i = 0; i < 26; ++i) f[i] = (const float*)d_in[i];
    p.out = (float*)d_out; p.ws = (unsigned char*)d_ws;
#if MK_SPLIT
    for (int k = 0; k < N_PHASES; ++k) { p.ph_lo = k; p.ph_hi = k + 1; hipLaunchKernelGGL(fwd_mega, dim3(grid), dim3(512), LDS_BYTES, stream, p); }
#else
    p.ph_lo = 0; p.ph_hi = N_PHASES;
    void* args[] = {&p};
    hipError_t e = hipLaunchCooperativeKernel((const void*)fwd_mega, dim3(grid), dim3(512), args, LDS_BYTES, stream);
    if (e != hipSuccess) fprintf(stderr, "cooperative launch failed: %s (grid %d)\n", hipGetErrorString(e), grid);
#endif
}
```

```cpp
#include <hip/hip_runtime.h>
#include <hip/hip_cooperative_groups.h>
#include <cstdio>
#include <cstdint>
namespace cg = cooperative_groups;

#define LAS __attribute__((address_space(3)))
#define DI __device__ __forceinline__
typedef unsigned short bf16_t;
typedef short bf16x8 __attribute__((ext_vector_type(8)));
typedef short s16x4 __attribute__((ext_vector_type(4)));
typedef float f32x4 __attribute__((ext_vector_type(4)));
typedef unsigned u32x4 __attribute__((ext_vector_type(4)));
typedef unsigned u32x2 __attribute__((ext_vector_type(2)));
typedef LAS unsigned char* lptr;
typedef _Float16 h16x2 __attribute__((ext_vector_type(2)));

constexpr int DM = 1024, SEQ = 4096, NB = 16, MP = NB * SEQ, MS = 1024, MT = MP + MS;
constexpr int DIN = 7424, DFF = 2816, NMEM = 256;
constexpr int C_RQ = 0, C_RK = 1024, C_RV = 2048, C_RG = 3072, C_SQ = 4096, C_SK = 5120, C_SV = 5248, C_GA = 5376, C_GB = 6400;
constexpr size_t GSZ = (size_t)MT * 1024, G_RQ = 0, G_RK = GSZ, G_RV = 2 * GSZ, G_RG = 3 * GSZ, G_SQ = 4 * GSZ, G_SKV = 5 * GSZ  , G_GA = G_SKV + (size_t)MT * 256, G_GB = G_GA + GSZ;
static_assert(G_GB + GSZ == (size_t)MT * DIN, "P groups");
constexpr float EPS = 1e-6f, LOG2E = 1.4426950408889634f;
constexpr size_t O_Y = 0, O_RSP = (size_t)MT * DM, O_RSS = O_RSP + 4194304, O_KP = O_RSS + 4194304, O_KS = O_KP + 262144, O_VP = O_KS + 262144,
                 O_VS = O_VP + 262144, O_MK = O_VS + 262144, O_MV = O_MK + 4194304;
constexpr size_t OB_XB = 0, OB_MB = (size_t)140 << 20;
constexpr size_t O_ROPE = O_RSP, O_RSTD1 = O_RSS, O_RSTDM = O_RSS + MT;
constexpr size_t WS_SSQR = 0, WS_SSQ2 = (size_t)MT * 16, WS_SSQ3 = WS_SSQ2 + (size_t)MT * 4, WS_SSQ4 = WS_SSQ3 + (size_t)MT * 4, WS_ZEND = WS_SSQ4 + (size_t)MT * 4;
constexpr size_t WS_WIN = (size_t)2 << 20, WS_WRO = WS_WIN + (size_t)DIN * DM * 2, WS_WSO = WS_WRO + 2097152, WS_WMX = WS_WSO + 2097152, WS_WCQ = WS_WMX + 2097152,
                 WS_WCO = WS_WCQ + 2097152, WS_WMKV = WS_WCO + 2097152, WS_WGU = WS_WMKV + 4194304, WS_WDN = WS_WGU + (size_t)2 * DFF * DM * 2, WS_WEND = WS_WDN + (size_t)DM * DFF * 2;
constexpr size_t WS_P = (size_t)48 << 20, WS_END = WS_P + (size_t)MT * DIN * 2;
static_assert(WS_ZEND <= WS_WIN && WS_WEND <= WS_P && WS_END <= ((size_t)1 << 30), "ws map");
constexpr size_t WS_XBUF = (WS_END + 255) / 256 * 256, WS_XCNT = WS_XBUF + (size_t)MP * 16, WS_END2 = WS_XCNT + 256 * 256;
constexpr size_t WS_MKVB = WS_END2, WS_CKVB = WS_MKVB + (size_t)NB * NMEM * 2048 * 2, WS_END3 = WS_CKVB + (size_t)NB * NMEM * 2048 * 2;
static_assert(WS_END3 <= ((size_t)1 << 30), "ws map 2");
constexpr int LDS_BYTES = 147456;

typedef float f32x2_t __attribute__((ext_vector_type(2)));
typedef __bf16 bf16x2_t __attribute__((ext_vector_type(2)));
DI unsigned cvt_pk_bf16(float lo, float hi) { const f32x2_t v = {lo, hi}; const bf16x2_t b = __builtin_convertvector(v, bf16x2_t); return __builtin_bit_cast(unsigned, b); }
DI float bf_lo(unsigned w) { return __uint_as_float(w << 16); }
DI float bf_hi(unsigned w) { return __uint_as_float(w & 0xffff0000u); }
DI void st8(bf16_t* p, f32x4 a, f32x4 b) { u32x4 w; w.x = cvt_pk_bf16(a.x, a.y); w.y = cvt_pk_bf16(a.z, a.w); w.z = cvt_pk_bf16(b.x, b.y); w.w = cvt_pk_bf16(b.z, b.w); *(u32x4*)p = w; }
DI void st8nt(bf16_t* p, f32x4 a, f32x4 b) { u32x4 w; w.x = cvt_pk_bf16(a.x, a.y); w.y = cvt_pk_bf16(a.z, a.w); w.z = cvt_pk_bf16(b.x, b.y); w.w = cvt_pk_bf16(b.z, b.w); __builtin_nontemporal_store(w, (u32x4*)p); }
DI void ld8(const bf16_t* p, f32x4& a, f32x4& b) { const u32x4 w = *(const u32x4*)p; a.x = bf_lo(w.x); a.y = bf_hi(w.x); a.z = bf_lo(w.y); a.w = bf_hi(w.y); b.x = bf_lo(w.z); b.y = bf_hi(w.z); b.z = bf_lo(w.w); b.w = bf_hi(w.w); }
DI float sigm(float x) { return __builtin_amdgcn_rcpf(1.f + __builtin_amdgcn_exp2f(-x * LOG2E)); }
DI f32x4 sigm4(f32x4 v) { f32x4 r; r.x = sigm(v.x); r.y = sigm(v.y); r.z = sigm(v.z); r.w = sigm(v.w); return r; }
DI float dot4(f32x4 a) { return (a.x * a.x + a.y * a.y) + (a.z * a.z + a.w * a.w); }
DI float wave_sum(float v) {
#pragma unroll
    for (int o = 1; o < 64; o <<= 1) v += __shfl_xor(v, o);
    return v;
}

namespace pg8 {
constexpr int BM = 256, BK = 64, HALF = 128, HTB = HALF * BK * 2, STAGE_BYTES = 8 * HTB, NXCD = 8, WGM = 8;
DI int lds_byte(int r, int c) { const int st = (r >> 4) * 2 + (c >> 5), rr = r & 15, cc = c & 31, ob = rr * 64 + cc * 2; return st * 1024 + (ob ^ (((ob >> 9) & 1) << 5)); }
DI void stage_rc(int b, int& R, int& C) { const int st = b / 1024, sb = b % 1024, swz = sb ^ (((sb >> 9) & 1) << 5); R = (st >> 1) * 16 + swz / 64; C = (st & 1) * 32 + (swz % 64) / 2; }
DI int perm32(int rho) { const int n = rho >> 4, i = rho & 15; return 8 * (i >> 2) + 4 * n + (i & 3); }
struct Unit { int pm, pn, r0, ui; };
struct Gemm { const bf16_t* A; int lda; const bf16_t* Bt; int M, N, K; };
struct StaticOrder {
    int nM, nN, nwg, G, c;
    DI void init(int M, int N, int G_, int c_) { nM = M / BM; nN = N / BM; nwg = nM * nN; G = G_; c = c_; }
    DI bool next(int i, Unit& u) const {
        const long L = (long)i * G + c; if (L >= nwg) return false;
        int wgid = (int)L; { const int q = nwg / NXCD, r = nwg % NXCD, xcd = wgid % NXCD, off = wgid / NXCD; wgid = (xcd < r ? xcd * (q + 1) : r * (q + 1) + (xcd - r) * q) + off; }
        const int nig = WGM * nN, gid = wgid / nig, fm = gid * WGM, gsz = (nM - fm) < WGM ? (nM - fm) : WGM;
        u.pm = fm + ((wgid % nig) % gsz); u.pn = (wgid % nig) / gsz; u.r0 = u.pm * BM; u.ui = i; return true;
    }
};
template <class Epi, bool ALIGN_EPI>
DI void gemm_phase(lptr lds, const Gemm g, const StaticOrder& S, const Epi& E) {
    const int tid = threadIdx.x, wid = __builtin_amdgcn_readfirstlane(tid >> 6), lane = tid & 63, wr = wid >> 2, wc = wid & 3, fr = lane & 15, fq = lane >> 4;
    const int K = g.K, nt = K / BK, lda = g.lda;
    unsigned voffA[2], voffB[2];
#pragma unroll
    for (int i = 0; i < 2; ++i) { int R, C; stage_rc(tid * 16 + i * 8192, R, C); const int Rb = (R & ~31) + perm32(R & 31);
        voffA[i] = (unsigned)(R * lda + C) * 2u; voffB[i] = (unsigned)(Rb * K + C) * 2u; }
    const size_t kstep = (size_t)(BK * 2);
    const size_t hstepA = (size_t)HALF * lda * 2, hstepB = (size_t)HALF * K * 2, tstepA = 2 * hstepA, tstepB = 2 * hstepB;
    const unsigned ldsw = (unsigned)wid * 1024u;
    const int aoff = lds_byte(wr * 64 + fr, fq * 8), boff = lds_byte(wc * 32 + fr, fq * 8);
#define PG8_SA(b, h) (((b) * 2 + (h)) * HTB)
#define PG8_SB(b, h) ((4 + (b) * 2 + (h)) * HTB)
#define PG8_STAGE(bufoff, gbase, voff) do { _Pragma("unroll") for (int _i = 0; _i < 2; ++_i) \
        __builtin_amdgcn_global_load_lds((const unsigned*)((const char*)(gbase) + (voff)[_i]), (LAS unsigned*)(lds + (bufoff) + ldsw + _i * 8192), 16, 0, 0); } while (0)
#define PG8_LDA(dst, b, h) do { _Pragma("unroll") for (int m = 0; m < 4; ++m) _Pragma("unroll") for (int k = 0; k < 2; ++k) dst[m][k] = *(const LAS bf16x8*)(lds + PG8_SA(b, h) + aoff + m * 2048 + k * 1024); } while (0)
#define PG8_LDB(dst, b, h) do { _Pragma("unroll") for (int n = 0; n < 2; ++n) _Pragma("unroll") for (int k = 0; k < 2; ++k) dst[n][k] = *(const LAS bf16x8*)(lds + PG8_SB(b, h) + boff + n * 2048 + k * 1024); } while (0)
#define PG8_MMA(ai, bj, At, Bt) do { __builtin_amdgcn_s_setprio(1); _Pragma("unroll") for (int m = 0; m < 4; ++m) _Pragma("unroll") for (int n = 0; n < 2; ++n) _Pragma("unroll") for (int k = 0; k < 2; ++k) \
        acc[ai][bj][m][n] = __builtin_amdgcn_mfma_f32_16x16x32_bf16(Bt[n][k], At[m][k], acc[ai][bj][m][n], 0, 0, 0); __builtin_amdgcn_s_setprio(0); } while (0)
#define PG8_WAIT_V(n) asm volatile("s_waitcnt vmcnt(" #n ")" ::: "memory")
#define PG8_WAIT_L(n) asm volatile("s_waitcnt lgkmcnt(" #n ")" ::: "memory")
#define PG8_BAR __builtin_amdgcn_s_barrier()
#define PG8_SCHED __builtin_amdgcn_sched_barrier(0)
    Unit cur, nxt; int ui = 0;
    if (!S.next(0, cur)) return;
    f32x4 acc[2][2][4][2];
#pragma unroll
    for (int a = 0; a < 2; ++a)
#pragma unroll
        for (int b = 0; b < 2; ++b)
#pragma unroll
            for (int m = 0; m < 4; ++m)
#pragma unroll
                for (int n = 0; n < 2; ++n) acc[a][b][m][n] = (f32x4){0.f, 0.f, 0.f, 0.f};
    bf16x8 At[4][2], B0[2][2], B1[2][2];
    const char* cA = (const char*)g.A + (size_t)cur.pm * tstepA; const char* cB = (const char*)g.Bt + (size_t)cur.pn * tstepB;
    if constexpr (Epi::RESCALE) E.prep(cur, tid);
    PG8_STAGE(PG8_SB(0, 0), cB, voffB); PG8_STAGE(PG8_SB(0, 1), cB + hstepB, voffB); PG8_STAGE(PG8_SA(0, 0), cA, voffA); PG8_STAGE(PG8_SA(0, 1), cA + hstepA, voffA);
    if (wr == 1) PG8_BAR;
    PG8_WAIT_V(2); PG8_BAR;
    PG8_STAGE(PG8_SB(1, 0), cB + kstep, voffB); PG8_STAGE(PG8_SA(1, 0), cA + kstep, voffA); PG8_STAGE(PG8_SB(1, 1), cB + hstepB + kstep, voffB);
    PG8_WAIT_V(6); PG8_BAR;
    for (;;) {
        const bool has_next = S.next(ui + 1, nxt);
        const char* nA = has_next ? (const char*)g.A + (size_t)nxt.pm * tstepA : cA; const char* nB = has_next ? (const char*)g.Bt + (size_t)nxt.pn * tstepB : cB;
        for (int t = 0; t < nt; t += 2) {
            const bool last = (t == nt - 2);
            if constexpr (Epi::RESCALE) { if (t == 4 || t == 8 || t == 12) E.rescale(acc, cur, t >> 2, wr, fr); }
            const char* a1 = cA + (size_t)(t + 1) * kstep;
            const char* a2 = last ? nA : cA + (size_t)(t + 2) * kstep; const char* b2 = last ? nB : cB + (size_t)(t + 2) * kstep;
            const char* a3 = a2 + kstep; const char* b3 = b2 + kstep;
            PG8_LDB(B0, 0, 0); PG8_LDB(B1, 0, 1); PG8_SCHED; PG8_LDA(At, 0, 0); PG8_STAGE(PG8_SA(1, 1), a1 + hstepA, voffA);
            PG8_WAIT_V(8); PG8_WAIT_L(0); PG8_BAR; PG8_MMA(0, 0, At, B0); PG8_MMA(0, 1, At, B1); PG8_BAR; PG8_SCHED;
            PG8_LDA(At, 0, 1); PG8_STAGE(PG8_SB(0, 0), b2, voffB); PG8_STAGE(PG8_SB(0, 1), b2 + hstepB, voffB); PG8_STAGE(PG8_SA(0, 0), a2, voffA);
            PG8_WAIT_V(8); PG8_WAIT_L(0); PG8_BAR; PG8_MMA(1, 0, At, B0); PG8_MMA(1, 1, At, B1); PG8_BAR; PG8_SCHED;
            PG8_LDB(B0, 1, 0); PG8_LDB(B1, 1, 1); PG8_SCHED; PG8_LDA(At, 1, 0); PG8_STAGE(PG8_SA(0, 1), a2 + hstepA, voffA);
            PG8_WAIT_V(8); PG8_WAIT_L(0); PG8_BAR; PG8_MMA(0, 0, At, B0); PG8_MMA(0, 1, At, B1); PG8_BAR; PG8_SCHED;
            PG8_LDA(At, 1, 1); PG8_STAGE(PG8_SB(1, 0), b3, voffB); PG8_STAGE(PG8_SB(1, 1), b3 + hstepB, voffB); PG8_STAGE(PG8_SA(1, 0), a3, voffA);
            PG8_WAIT_V(8); PG8_WAIT_L(0); PG8_BAR; PG8_MMA(1, 0, At, B0); PG8_MMA(1, 1, At, B1); PG8_BAR; PG8_SCHED;
        }
        if constexpr (ALIGN_EPI) { if (wr == 0) PG8_BAR; }
        E.template run<2>(acc, cur, wr, wc, fr, fq);
        if (!has_next) break;
#pragma unroll
        for (int a = 0; a < 2; ++a)
#pragma unroll
            for (int b = 0; b < 2; ++b)
#pragma unroll
                for (int m = 0; m < 4; ++m)
#pragma unroll
                    for (int n = 0; n < 2; ++n) acc[a][b][m][n] = (f32x4){0.f, 0.f, 0.f, 0.f};
        cur = nxt; cA = nA; cB = nB; ++ui;
        if constexpr (Epi::RESCALE) E.prep(cur, tid);
        if constexpr (ALIGN_EPI) { if (wr == 1) PG8_BAR; }
    }
    PG8_WAIT_V(0);
    if constexpr (!ALIGN_EPI) { if (wr == 0) PG8_BAR; }
    PG8_BAR;
#undef PG8_SA
#undef PG8_SB
#undef PG8_STAGE
#undef PG8_LDA
#undef PG8_LDB
#undef PG8_MMA
#undef PG8_WAIT_V
#undef PG8_WAIT_L
#undef PG8_BAR
#undef PG8_SCHED
}
}
typedef short v4i16_t __attribute__((ext_vector_type(4)));
DI bf16x8 lds16(lptr p) { return *(const LAS bf16x8*)p; }
DI s16x4 ldstr(lptr p) { return __builtin_bit_cast(s16x4, __builtin_amdgcn_ds_read_tr16_b64_v4i16((LAS v4i16_t*)p)); }
DI bf16x8 tr_pair(lptr p0, lptr p1) { const s16x4 a = ldstr(p0), b = ldstr(p1); return (bf16x8){a.x, a.y, a.z, a.w, b.x, b.y, b.z, b.w}; }
DI bf16x8 pack8(f32x4 a, f32x4 b) { u32x4 w; w.x = cvt_pk_bf16(a.x, a.y); w.y = cvt_pk_bf16(a.z, a.w); w.z = cvt_pk_bf16(b.x, b.y); w.w = cvt_pk_bf16(b.z, b.w); return __builtin_bit_cast(bf16x8, w); }
DI u32x2 pack4(f32x4 a) { u32x2 w; w.x = cvt_pk_bf16(a.x, a.y); w.y = cvt_pk_bf16(a.z, a.w); return w; }
DI f32x4 mfma16(bf16x8 a, bf16x8 b, f32x4 c) { return __builtin_amdgcn_mfma_f32_16x16x32_bf16(a, b, c, 0, 0, 0); }
DI float ex2(float x) { return __builtin_amdgcn_exp2f(x); }
DI void lds_barrier() { asm volatile("s_waitcnt lgkmcnt(0)" ::: "memory"); __builtin_amdgcn_s_barrier(); asm volatile("" ::: "memory"); }

using pg8::Unit;
#define EPI_ROW(ai, m) (u.r0 + (ai) * 128 + wr * 64 + (m) * 16 + fr)
typedef const f32x4 (&AccRef)[2][2][4][2];

DI float f16lo(unsigned w) { return (float)__builtin_bit_cast(h16x2, w).x; }
DI float f16hi(unsigned w) { return (float)__builtin_bit_cast(h16x2, w).y; }
struct EpiInProj {
    static constexpr bool RESCALE = false;
    bf16_t* P; const float* rstd; const unsigned* rope;
    template <int NAI> DI void run(AccRef acc, const Unit& u, int wr, int wc, int fr, int fq) const {
        const int pn = u.pn, cl = wc * 32 + fq * 8;
        bf16_t* const gbase = pn < 20 ? P + (size_t)(pn >> 2) * GSZ + (pn & 3) * 256 : pn == 20 ? P + G_SKV : P + G_GA + (size_t)((pn - 21) >> 2) * GSZ + ((pn - 21) & 3) * 256;
        const unsigned pitch = pn == 20 ? 256u : 1024u;
        float rsv[2][4];
#pragma unroll
        for (int ai = 0; ai < NAI; ++ai)
#pragma unroll
            for (int m = 0; m < 4; ++m) rsv[ai][m] = rstd[EPI_ROW(ai, m)];
#pragma unroll
        for (int ai = 0; ai < NAI; ++ai) {
            if (pn < 8) {
                u32x4 cs[4][2];
#pragma unroll
                for (int m = 0; m < 4; ++m) { const int row = EPI_ROW(ai, m); const int pos = row < MP ? (row & (SEQ - 1)) : (SEQ + ((row - MP) & 63));
                    const unsigned* tp = rope + pos * 128 + cl; cs[m][0] = *(const u32x4*)tp; cs[m][1] = *(const u32x4*)(tp + 4); }
#pragma unroll
                for (int m = 0; m < 4; ++m) { const int row = EPI_ROW(ai, m); bf16_t* prow = gbase + ((unsigned)row * pitch + (unsigned)cl);
                    const float sc = pn >= 4 ? rsv[ai][m] * 0.0625f : rsv[ai][m];
                    const u32x4 w0 = cs[m][0], w1 = cs[m][1];
                    const f32x4 c0 = (f32x4){f16lo(w0.x), f16lo(w0.y), f16lo(w0.z), f16lo(w0.w)}, s0 = (f32x4){f16hi(w0.x), f16hi(w0.y), f16hi(w0.z), f16hi(w0.w)};
                    const f32x4 c1 = (f32x4){f16lo(w1.x), f16lo(w1.y), f16lo(w1.z), f16lo(w1.w)}, s1 = (f32x4){f16hi(w1.x), f16hi(w1.y), f16hi(w1.z), f16hi(w1.w)};
                    const f32x4 x10 = acc[ai][0][m][0] * sc, x11 = acc[ai][0][m][1] * sc, x20 = acc[ai][1][m][0] * sc, x21 = acc[ai][1][m][1] * sc;
                    st8(prow, x10 * c0 - x20 * s0, x11 * c1 - x21 * s1);
                    st8(prow + 128, x20 * c0 + x10 * s0, x21 * c1 + x11 * s1); }
            } else {
#pragma unroll
                for (int m = 0; m < 4; ++m) { const int row = EPI_ROW(ai, m); bf16_t* prow = gbase + ((unsigned)row * pitch + (unsigned)cl); const float rs = rsv[ai][m];
#pragma unroll
                    for (int bj = 0; bj < 2; ++bj) {
                        f32x4 a = acc[ai][bj][m][0] * rs, b = acc[ai][bj][m][1] * rs;
                        if (pn >= 12 && pn < 16) { a = a * sigm4(a); b = b * sigm4(b); }
                        else if (pn >= 16 && pn < 20) { a = a * 0.125f; b = b * 0.125f; }
                        else if (pn >= 21) { a = sigm4(a); b = sigm4(b); }
                        st8(prow + bj * 128, a, b);
                    } }
            }
        }
    }
};
struct EpiMemKV {
    static constexpr bool RESCALE = false;
    float* mk; float* mv; const float* rstd; bf16_t* kvb;
    template <int NAI> DI void run(AccRef acc, const Unit& u, int wr, int wc, int fr, int fq) const {
        const int pn = u.pn, cl = wc * 32 + fq * 8; float* base = pn < 4 ? mk : mv;
        float rsv[2][4];
#pragma unroll
        for (int ai = 0; ai < NAI; ++ai)
#pragma unroll
            for (int m = 0; m < 4; ++m) rsv[ai][m] = rstd[EPI_ROW(ai, m)];
#pragma unroll
        for (int ai = 0; ai < NAI; ++ai)
#pragma unroll
            for (int m = 0; m < 4; ++m) {
                const int row = EPI_ROW(ai, m); const float rs = rsv[ai][m];
#pragma unroll
                for (int bj = 0; bj < 2; ++bj) { float* d = base + (size_t)row * DM + (pn & 3) * 256 + bj * 128 + cl;
                    const f32x4 a = acc[ai][bj][m][0] * rs, b = acc[ai][bj][m][1] * rs;
                    *(f32x4*)d = a; *(f32x4*)(d + 4) = b; st8(kvb + (size_t)row * 2048 + pn * 256 + bj * 128 + cl, a, b); }
            }
    }
};
DI void unpack8(const u32x4 w, f32x4& a, f32x4& b) { a.x = bf_lo(w.x); a.y = bf_hi(w.x); a.z = bf_lo(w.y); a.w = bf_hi(w.y); b.x = bf_lo(w.z); b.y = bf_hi(w.z); b.z = bf_lo(w.w); b.w = bf_hi(w.w); }
struct EpiSwaOut {
    static constexpr bool RESCALE = false;
    bf16_t* P;
    template <int NAI> DI void run(AccRef acc, const Unit& u, int wr, int wc, int fr, int fq) const {
        const int cl = u.pn * 256 + wc * 32 + fq * 8;
#pragma unroll
        for (int ai = 0; ai < NAI; ++ai) {
            u32x4 gv[4][2];
#pragma unroll
            for (int m = 0; m < 4; ++m)
#pragma unroll
                for (int bj = 0; bj < 2; ++bj) gv[m][bj] = *(const u32x4*)(P + G_GB + (size_t)EPI_ROW(ai, m) * 1024 + cl + bj * 128);
#pragma unroll
            for (int m = 0; m < 4; ++m)
#pragma unroll
                for (int bj = 0; bj < 2; ++bj) { f32x4 ga, gb; unpack8(gv[m][bj], ga, gb);
                    st8(P + G_GB + (size_t)EPI_ROW(ai, m) * 1024 + cl + bj * 128, acc[ai][bj][m][0] * ga, acc[ai][bj][m][1] * gb); }
        }
    }
};
struct EpiRetOut {
    static constexpr bool RESCALE = true;
    bf16_t* P; const float* ssqr; lptr tbl;
    DI f32x4 factors(int row) const { const f32x4 q = *(const f32x4*)(ssqr + (size_t)row * 4);
        const float s0 = __builtin_amdgcn_rsqf(q.x * (1.f / 256.f) + EPS), s1 = __builtin_amdgcn_rsqf(q.y * (1.f / 256.f) + EPS), s2 = __builtin_amdgcn_rsqf(q.z * (1.f / 256.f) + EPS), s3 = __builtin_amdgcn_rsqf(q.w * (1.f / 256.f) + EPS);
        return (f32x4){s0 * __builtin_amdgcn_rcpf(s1), s1 * __builtin_amdgcn_rcpf(s2), s2 * __builtin_amdgcn_rcpf(s3), s3}; }
    DI void prep(const Unit& u, int tid) const { if (tid < 256) *(LAS f32x4*)(tbl + (u.ui & 1) * 4096 + tid * 16) = factors(u.r0 + tid); }
    DI void rescale(f32x4 (&acc)[2][2][4][2], const Unit& u, int h, int wr, int fr) const {
        const LAS float* T = (const LAS float*)(tbl + (u.ui & 1) * 4096);
#pragma unroll
        for (int ai = 0; ai < 2; ++ai)
#pragma unroll
            for (int m = 0; m < 4; ++m) { const float r = T[(ai * 128 + wr * 64 + m * 16 + fr) * 4 + (h - 1)];
#pragma unroll
                for (int bj = 0; bj < 2; ++bj)
#pragma unroll
                    for (int n = 0; n < 2; ++n) acc[ai][bj][m][n] = acc[ai][bj][m][n] * r; }
    }
    template <int NAI> DI void run(AccRef acc, const Unit& u, int wr, int wc, int fr, int fq) const {
        const int cl = u.pn * 256 + wc * 32 + fq * 8;
        const LAS float* T = (const LAS float*)(tbl + (u.ui & 1) * 4096);
        float s3v[2][4];
#pragma unroll
        for (int ai = 0; ai < NAI; ++ai)
#pragma unroll
            for (int m = 0; m < 4; ++m) s3v[ai][m] = NAI == 2 ? T[(ai * 128 + wr * 64 + m * 16 + fr) * 4 + 3] : factors(EPI_ROW(ai, m)).w;
#pragma unroll
        for (int ai = 0; ai < NAI; ++ai)
#pragma unroll
        for (int mh = 0; mh < 4; mh += 2) {
            u32x4 gv[4][2], mv[4][2];
#pragma unroll
            for (int m = mh; m < mh + 2; ++m)
#pragma unroll
                for (int bj = 0; bj < 2; ++bj) { const bf16_t* g = P + G_GA + (size_t)EPI_ROW(ai, m) * 1024 + cl + bj * 128; gv[m][bj] = *(const u32x4*)g; mv[m][bj] = *(const u32x4*)(g + (G_GB - G_GA)); }
#pragma unroll
            for (int m = mh; m < mh + 2; ++m)
#pragma unroll
                for (int bj = 0; bj < 2; ++bj) { f32x4 ga, gb, ma, mb; unpack8(gv[m][bj], ga, gb); unpack8(mv[m][bj], ma, mb); const float s3 = s3v[ai][m];
                    st8(P + G_GA + (size_t)EPI_ROW(ai, m) * 1024 + cl + bj * 128, acc[ai][bj][m][0] * s3 * ga + ma, acc[ai][bj][m][1] * s3 * gb + mb); }
        }
    }
};
template <bool FROM_X, bool WRITE_HB> struct EpiResid {
    static constexpr bool RESCALE = false;
    const float* xp; const float* xs; float* H; bf16_t* P; float* ssq;
    template <int NAI> DI void run(AccRef acc, const Unit& u, int wr, int wc, int fr, int fq) const {
        const int cl = u.pn * 256 + wc * 32 + fq * 8;
#pragma unroll
        for (int ai = 0; ai < NAI; ++ai)
#pragma unroll
        for (int mh = 0; mh < 4; mh += 2) {
            f32x4 xv[4][2][2];
#pragma unroll
            for (int m = mh; m < mh + 2; ++m) { const int row = EPI_ROW(ai, m);
                const float* src = FROM_X ? (row < MP ? xp + (size_t)row * DM : xs + (size_t)(row - MP) * DM) : H + (size_t)row * DM;
#pragma unroll
                for (int bj = 0; bj < 2; ++bj) { xv[m][bj][0] = *(const f32x4*)(src + cl + bj * 128); xv[m][bj][1] = *(const f32x4*)(src + cl + bj * 128 + 4); } }
#pragma unroll
            for (int m = mh; m < mh + 2; ++m) { const int row = EPI_ROW(ai, m); float ss = 0.f;
#pragma unroll
                for (int bj = 0; bj < 2; ++bj) { const int col = cl + bj * 128;
                    const f32x4 a = xv[m][bj][0] + acc[ai][bj][m][0], b = xv[m][bj][1] + acc[ai][bj][m][1];
                    *(f32x4*)(H + (size_t)row * DM + col) = a; *(f32x4*)(H + (size_t)row * DM + col + 4) = b;
                    if (WRITE_HB) st8(P + G_RQ + (size_t)row * 1024 + col, a, b);
                    ss += dot4(a) + dot4(b); }
                ss += __shfl_xor(ss, 16); ss += __shfl_xor(ss, 32);
                if (fq == 0) unsafeAtomicAdd(ssq + row, ss); }
        }
    }
};
struct EpiCq {
    static constexpr bool RESCALE = false;
    bf16_t* P; const float* ssq;
    template <int NAI> DI void run(AccRef acc, const Unit& u, int wr, int wc, int fr, int fq) const {
        const int cl = u.pn * 256 + wc * 32 + fq * 8;
        float rsv[2][4];
#pragma unroll
        for (int ai = 0; ai < NAI; ++ai)
#pragma unroll
            for (int m = 0; m < 4; ++m) rsv[ai][m] = ssq[EPI_ROW(ai, m)];
#pragma unroll
        for (int ai = 0; ai < NAI; ++ai)
#pragma unroll
            for (int m = 0; m < 4; ++m) {
                const int row = EPI_ROW(ai, m); const float rs = 0.0625f * __builtin_amdgcn_rsqf(rsv[ai][m] * (1.f / DM) + EPS);
#pragma unroll
                for (int bj = 0; bj < 2; ++bj) st8(P + G_RK + (size_t)row * 1024 + cl + bj * 128, acc[ai][bj][m][0] * rs, acc[ai][bj][m][1] * rs);
            }
    }
};
struct EpiGateUp {
    static constexpr bool RESCALE = false;
    bf16_t* P; const float* ssq;
    template <int NAI> DI void run(AccRef acc, const Unit& u, int wr, int wc, int fr, int fq) const {
        const int cl = u.pn * 128 + wc * 32 + fq * 8;
        float rsv[2][4];
#pragma unroll
        for (int ai = 0; ai < NAI; ++ai)
#pragma unroll
            for (int m = 0; m < 4; ++m) rsv[ai][m] = ssq[EPI_ROW(ai, m)];
#pragma unroll
        for (int ai = 0; ai < NAI; ++ai)
#pragma unroll
            for (int m = 0; m < 4; ++m) {
                const int row = EPI_ROW(ai, m); const float rs = __builtin_amdgcn_rsqf(rsv[ai][m] * (1.f / DM) + EPS);
                const f32x4 g0 = acc[ai][0][m][0] * rs, g1 = acc[ai][0][m][1] * rs, u0 = acc[ai][1][m][0] * rs, u1 = acc[ai][1][m][1] * rs;
                st8nt(P + G_RV + (size_t)row * DFF + cl, g0 * sigm4(g0) * u0, g1 * sigm4(g1) * u1);
            }
    }
};
struct EpiDownFinal {
    static constexpr bool RESCALE = false;
    float* H; const float* gfin; float* xbuf; unsigned* cnt; lptr xl;
    template <int NAI> DI void run(AccRef acc, const Unit& u, int wr, int wc, int fr, int fq) const {
        static_assert(NAI == 2, "full units only");
        const int tid = threadIdx.x, wid = __builtin_amdgcn_readfirstlane(tid >> 6), lane = tid & 63;
        const int cl = u.pn * 256 + wc * 32 + fq * 8;
        LAS float* Pt = (LAS float*)xl; LAS float* St = (LAS float*)(xl + 4096); LAS unsigned* flag = (LAS unsigned*)(xl + 5120);
        f32x4 v[2][2][4][2];
#pragma unroll
        for (int ai = 0; ai < 2; ++ai)
#pragma unroll
            for (int m = 0; m < 4; ++m) { const int row = EPI_ROW(ai, m); float ss = 0.f;
#pragma unroll
                for (int bj = 0; bj < 2; ++bj) { const float* h = H + (size_t)row * DM + cl + bj * 128;
                    v[ai][bj][m][0] = *(const f32x4*)h + acc[ai][bj][m][0]; v[ai][bj][m][1] = *(const f32x4*)(h + 4) + acc[ai][bj][m][1];
                    ss += dot4(v[ai][bj][m][0]) + dot4(v[ai][bj][m][1]); }
                ss += __shfl_xor(ss, 16); ss += __shfl_xor(ss, 32);
                if (fq == 0) Pt[(ai * 128 + wr * 64 + m * 16 + fr) * 4 + wc] = ss; }
        lds_barrier();
        if (tid < 256) { const float tot = (Pt[tid * 4 + 0] + Pt[tid * 4 + 1]) + (Pt[tid * 4 + 2] + Pt[tid * 4 + 3]);
            __hip_atomic_store(xbuf + (size_t)(u.r0 + tid) * 4 + u.pn, tot, __ATOMIC_RELAXED, __HIP_MEMORY_SCOPE_AGENT);
            asm volatile("s_waitcnt vmcnt(0)" ::: "memory");
            if (lane == 0) __hip_atomic_fetch_add(cnt + 64 * u.pm, 1u, __ATOMIC_RELAXED, __HIP_MEMORY_SCOPE_AGENT); }
        if (wid == 0) { unsigned sp = 0;
            while ((unsigned)__builtin_amdgcn_readfirstlane(__hip_atomic_load(cnt + 64 * u.pm, __ATOMIC_RELAXED, __HIP_MEMORY_SCOPE_AGENT)) < 16u) { __builtin_amdgcn_s_sleep(2); if (++sp > (1u << 22)) break; }
            __builtin_amdgcn_fence(__ATOMIC_ACQUIRE, "agent");
            if (lane == 0) flag[0] = 1u; }
        asm volatile("s_waitcnt vmcnt(0)" ::: "memory");
        lds_barrier();
        if (tid < 256) { const float* sl = xbuf + (size_t)(u.r0 + tid) * 4; float q = 0.f;
#pragma unroll
            for (int t = 0; t < 4; ++t) q += __hip_atomic_load(sl + t, __ATOMIC_RELAXED, __HIP_MEMORY_SCOPE_AGENT);
            St[tid] = __builtin_amdgcn_rsqf(q * (1.f / DM) + EPS); }
        lds_barrier();
#pragma unroll
        for (int bj = 0; bj < 2; ++bj) { const f32x4 g0 = *(const f32x4*)(gfin + cl + bj * 128), g1 = *(const f32x4*)(gfin + cl + bj * 128 + 4);
#pragma unroll
            for (int ai = 0; ai < 2; ++ai)
#pragma unroll
                for (int m = 0; m < 4; ++m) { const int rl = ai * 128 + wr * 64 + m * 16 + fr; const float rs = St[rl]; float* o = H + (size_t)(u.r0 + rl) * DM + cl + bj * 128;
                    __builtin_nontemporal_store(v[ai][bj][m][0] * g0 * rs, (f32x4*)o); __builtin_nontemporal_store(v[ai][bj][m][1] * g1 * rs, (f32x4*)(o + 4)); } }
    }
};

template <class Epi>
DI void mini_gemm_phase(lptr L, const pg8::Gemm g, const int row_base, const Epi& E) {
    const int tid = threadIdx.x, wid = __builtin_amdgcn_readfirstlane(tid >> 6), lane = tid & 63, kh = wid >> 2, wc = wid & 3, fr = lane & 15, fq = lane >> 4;
    const int nN = g.N / 256, nItems = (g.M / 64) * nN, G = gridDim.x, nt = g.K / 64;
    constexpr int PB = 144, ST_A = 0, ST_B = 9216, ST_SZ = 46080;
    const int arow = tid >> 3, ach = tid & 7;
    for (int it = blockIdx.x; it < nItems; it += G) {
        const int im = it / nN, in = it % nN;
        const bf16_t* Ab = g.A + (size_t)(im * 64 + arow) * g.lda + ach * 8;
        const bf16_t* Bb = g.Bt + (size_t)(in * 256 + arow) * g.K + ach * 8;
        u32x4 ra[4], rb[4][4];
#pragma unroll
        for (int j = 0; j < 4; ++j) { ra[j] = *(const u32x4*)(Ab + j * 64);
#pragma unroll
            for (int k = 0; k < 4; ++k) rb[j][k] = *(const u32x4*)(Bb + (size_t)(64 * k) * g.K + j * 64); }
        f32x4 acc[2][2][4][2];
#pragma unroll
        for (int a = 0; a < 2; ++a)
#pragma unroll
            for (int b = 0; b < 2; ++b)
#pragma unroll
                for (int m = 0; m < 4; ++m)
#pragma unroll
                    for (int n = 0; n < 2; ++n) acc[a][b][m][n] = (f32x4){0.f, 0.f, 0.f, 0.f};
#pragma unroll 1
        for (int t = 0; t < nt; t += 4) {
            if constexpr (Epi::RESCALE) { if (t > 0) {
#pragma unroll
                for (int m = 0; m < 4; ++m) { const f32x4 fz = E.factors(row_base + im * 64 + 16 * m + fr); const float r = (t == 4) ? fz.x : (t == 8) ? fz.y : fz.z;
#pragma unroll
                    for (int bj = 0; bj < 2; ++bj)
#pragma unroll
                        for (int n = 0; n < 2; ++n) acc[0][bj][m][n] = acc[0][bj][m][n] * r; } } }
#pragma unroll
            for (int j = 0; j < 4; ++j) {
                lptr S = L + (j & 1) * ST_SZ;
                *(LAS u32x4*)(S + ST_A + arow * PB + ach * 16) = ra[j];
#pragma unroll
                for (int k = 0; k < 4; ++k) *(LAS u32x4*)(S + ST_B + (arow + 64 * k) * PB + ach * 16) = rb[j][k];
                lds_barrier();
                if (t + j + 4 < nt) { ra[j] = *(const u32x4*)(Ab + (t + j + 4) * 64);
#pragma unroll
                    for (int k = 0; k < 4; ++k) rb[j][k] = *(const u32x4*)(Bb + (size_t)(64 * k) * g.K + (t + j + 4) * 64); }
                bf16x8 af[4], bf[2][2];
#pragma unroll
                for (int m = 0; m < 4; ++m) af[m] = lds16(S + ST_A + (16 * m + fr) * PB + (32 * kh + 8 * fq) * 2);
#pragma unroll
                for (int bj = 0; bj < 2; ++bj)
#pragma unroll
                    for (int n = 0; n < 2; ++n) bf[bj][n] = lds16(S + ST_B + (128 * bj + 32 * wc + pg8::perm32(16 * n + fr)) * PB + (32 * kh + 8 * fq) * 2);
#pragma unroll
                for (int bj = 0; bj < 2; ++bj)
#pragma unroll
                    for (int m = 0; m < 4; ++m)
#pragma unroll
                        for (int n = 0; n < 2; ++n) acc[0][bj][m][n] = mfma16(bf[bj][n], af[m], acc[0][bj][m][n]);
            }
        }
        lds_barrier();
        if (kh == 1) {
#pragma unroll
            for (int bj = 0; bj < 2; ++bj)
#pragma unroll
                for (int m = 0; m < 4; ++m)
#pragma unroll
                    for (int n = 0; n < 2; ++n) *(LAS f32x4*)(L + ((wc * 16 + bj * 8 + m * 2 + n) * 64 + lane) * 16) = acc[0][bj][m][n];
        }
        lds_barrier();
        if (kh == 0) {
#pragma unroll
            for (int bj = 0; bj < 2; ++bj)
#pragma unroll
                for (int m = 0; m < 4; ++m)
#pragma unroll
                    for (int n = 0; n < 2; ++n) acc[0][bj][m][n] += *(const LAS f32x4*)(L + ((wc * 16 + bj * 8 + m * 2 + n) * 64 + lane) * 16);
            Unit u; u.pm = 0; u.pn = in; u.r0 = row_base + im * 64; u.ui = 0;
            E.template run<1>(acc, u, 0, wc, fr, fq);
        }
        lds_barrier();
    }
}
struct Params {
    const float *xp, *xs, *crs, *csk, *csv, *cmk, *cmv, *memp, *relb, *g_attn, *w_in, *w_ro, *w_so, *w_mx, *sinks, *g_cross, *g_mem, *w_cq, *w_mk, *w_mv, *w_co,
                *g_ffn, *w_gate, *w_up, *w_down, *g_final;
    float* out; unsigned char* ws; int ph_lo, ph_hi;
};

DI void transpose_item(const float* W, int N, const float* gain, bf16_t* WT, int ldk, int k0, int n0, int drow0, LAS float* scr, int lane) {
#pragma unroll 8
    for (int i = 0; i < 32; ++i) { const int kk = 2 * i + (lane >> 5); const float g = gain ? gain[k0 + kk] : 1.f; scr[kk * 33 + (lane & 31)] = W[(size_t)(k0 + kk) * N + n0 + (lane & 31)] * g; }
    asm volatile("s_waitcnt lgkmcnt(0)" ::: "memory");
    const int c = lane & 7;
#pragma unroll
    for (int j = 0; j < 4; ++j) { const int n = (lane >> 3) + 8 * j; const LAS float* s = scr + (8 * c) * 33 + n;
        u32x4 o; o.x = cvt_pk_bf16(s[0 * 33], s[1 * 33]); o.y = cvt_pk_bf16(s[2 * 33], s[3 * 33]); o.z = cvt_pk_bf16(s[4 * 33], s[5 * 33]); o.w = cvt_pk_bf16(s[6 * 33], s[7 * 33]);
        *(u32x4*)(WT + (size_t)(drow0 + n) * ldk + k0 + 8 * c) = o; }
    asm volatile("s_waitcnt lgkmcnt(0)" ::: "memory");
}
DI void row_to_bf16(const float* xrow, bf16_t* orow, float* rstd_out, int lane) {
    const f32x4* xr = (const f32x4*)xrow + lane; f32x4 v[4]; float s = 0.f;
#pragma unroll
    for (int j = 0; j < 4; ++j) { v[j] = xr[64 * j]; s += dot4(v[j]); }
    s = wave_sum(s);
    if (lane == 0) *rstd_out = 1.f / sqrtf(s * (1.f / DM) + EPS);
    u32x2* o8 = (u32x2*)orow + lane;
#pragma unroll
    for (int j = 0; j < 4; ++j) o8[64 * j] = pack4(v[j]);
}
DI void phase_prep(const Params& p, lptr L, int tid, int lane, int wave) {
    LAS float* scr = (LAS float*)(L + wave * 8448);
    const int G = gridDim.x, gw = blockIdx.x * 8 + wave, NGW = G * 8;
    unsigned char* ws = p.ws;
    constexpr int I_IN = 16 * 232, I_SQ = 512, I_FF = 16 * 88, I_DN = 44 * 32;
    constexpr int NITEMS = I_IN + 7 * I_SQ + 2 * I_FF + I_DN;
    for (int it = gw; it < NITEMS; it += NGW) {
        int r = it;
        if (r < I_IN) { const int kb = r / 232, nb = r % 232; transpose_item(p.w_in, DIN, p.g_attn, (bf16_t*)(ws + WS_WIN), DM, kb * 64, nb * 32, nb * 32, scr, lane); continue; } r -= I_IN;
        if (r < 7 * I_SQ) { const int mi = r / I_SQ, q = r % I_SQ, kb = q / 32, nb = q % 32;
            const float* W = mi == 0 ? p.w_ro : mi == 1 ? p.w_so : mi == 2 ? p.w_mx : mi == 3 ? p.w_cq : mi == 4 ? p.w_co : mi == 5 ? p.w_mk : p.w_mv;
            const float* gn = mi == 3 ? p.g_cross : (mi >= 5 ? p.g_mem : nullptr);
            bf16_t* WT = (bf16_t*)(ws + (mi == 0 ? WS_WRO : mi == 1 ? WS_WSO : mi == 2 ? WS_WMX : mi == 3 ? WS_WCQ : mi == 4 ? WS_WCO : WS_WMKV));
            transpose_item(W, DM, gn, WT, DM, kb * 64, nb * 32, (mi == 6 ? 1024 : 0) + nb * 32, scr, lane); continue; } r -= 7 * I_SQ;
        if (r < 2 * I_FF) { const int up = r / I_FF, q = r % I_FF, kb = q / 88, nb = q % 88, n0 = nb * 32;
            transpose_item(up ? p.w_up : p.w_gate, DFF, p.g_ffn, (bf16_t*)(ws + WS_WGU), DM, kb * 64, n0, 256 * (n0 / 128) + (n0 % 128) + up * 128, scr, lane); continue; } r -= 2 * I_FF;
        { const int kb = r / 32, nb = r % 32; transpose_item(p.w_down, DM, nullptr, (bf16_t*)(ws + WS_WDN), DFF, kb * 64, nb * 32, nb * 32, scr, lane); }
    }
    bf16_t* XB = (bf16_t*)((unsigned char*)p.out + OB_XB); bf16_t* MB = (bf16_t*)((unsigned char*)p.out + OB_MB);
    for (int m = 2 * gw; m < MT; m += 2 * NGW) {
        const float* xa = m < MP ? p.xp + (size_t)m * DM : p.xs + (size_t)(m - MP) * DM; const f32x4* xr = (const f32x4*)xa + lane; f32x4 v[8]; float s0 = 0.f, s1 = 0.f;
#pragma unroll
        for (int j = 0; j < 8; ++j) v[j] = xr[64 * j];
#pragma unroll
        for (int j = 0; j < 4; ++j) { s0 += dot4(v[j]); s1 += dot4(v[4 + j]); }
        s0 = wave_sum(s0); s1 = wave_sum(s1);
        if (lane == 0) { p.out[O_RSTD1 + m] = 1.f / sqrtf(s0 * (1.f / DM) + EPS); p.out[O_RSTD1 + m + 1] = 1.f / sqrtf(s1 * (1.f / DM) + EPS); }
        u32x2* o8 = (u32x2*)(XB + (size_t)m * DM) + lane;
#pragma unroll
        for (int j = 0; j < 8; ++j) o8[64 * j] = pack4(v[j]);
    }
    { bf16_t* CB = (bf16_t*)(ws + WS_CKVB);
      for (int m = gw; m < 2 * NB * NMEM; m += NGW) { const int r = m >> 1, isv = m & 1; const f32x4* src = (const f32x4*)((isv ? p.cmv : p.cmk) + (size_t)r * DM) + lane; u32x2* o8 = (u32x2*)(CB + (size_t)r * 2048 + isv * 1024) + lane;
#pragma unroll
          for (int j = 0; j < 4; ++j) o8[64 * j] = pack4(src[64 * j]); } }
    for (int m = gw; m < NB * NMEM; m += NGW) row_to_bf16(p.memp + (size_t)m * DM, MB + (size_t)m * DM, p.out + O_RSTDM + m, lane);
    const int gt = blockIdx.x * 512 + tid, GT = G * 512;
    for (int i = gt; i < 4160 * 128; i += GT) { const int pos = i >> 7, j = i & 127; const float inv = exp2f(-(float)j * (13.287712379549449f / 128.f)); const float ang = (float)pos * inv;
        float s, c; sincosf(ang, &s, &c); const h16x2 cs = {(_Float16)c, (_Float16)s}; ((unsigned*)(p.out + O_ROPE))[i] = __builtin_bit_cast(unsigned, cs); }
    float* z = (float*)(ws + WS_SSQR);
    for (int i = gt; i < MT * 7; i += GT) z[i] = 0.f;
    unsigned* xc = (unsigned*)(ws + WS_XCNT);
    for (int i = gt; i < 256 * 64; i += GT) xc[i] = 0u;
}

constexpr int R_QS = 0, R_KS = 33792, R_VS = 67584, R_VD = 77824, R_ST = 87040, R_END = 123904, QP = 528, VP = 144, VP2 = 160, QP2 = 544;
constexpr int L_BIAS = 124928;
DI void retention_stream(const Params& p, lptr L, int stream, int tid, int lane, int wave, const bool dry = false, const int pmode = 0) {
    const bool samp = stream >= 256; const int sid = stream & 255, b = sid >> 4, h = (sid >> 2) & 3, sl = sid & 3;
    const int nch = samp ? 1 : 64; const int rowb = samp ? MP + b * 64 : b * SEQ;
    bf16_t* P = (bf16_t*)(p.ws + WS_P); float* ssqr = (float*)(p.ws + WS_SSQR);
    const int l15 = lane & 15, g4 = lane >> 4;
    const float l2g = log2f(1.f - exp2f(-5.f - (float)h));
    const float g64 = ex2(64.f * l2g);
    const int nt = wave >> 1, mtb = 2 * (wave & 1);
    const int vrow = tid >> 3, vch = tid & 7;
    const float vdec = ex2((float)(63 - vrow) * l2g);
    u32x4 pq[4], pk[4], pv; u32x2 rgc[2];
    const bf16_t* Qb = P + G_RQ + (size_t)rowb * 1024 + h * 256; const bf16_t* Kb = Qb + GSZ;
    bf16_t* Vb = P + G_RV + (size_t)rowb * 1024 + h * 256 + sl * 64; const bf16_t* Rb = P + G_RG + (size_t)rowb * 1024 + h * 256 + sl * 64;
    const unsigned qoff = (unsigned)((tid >> 5) * 1024 + (tid & 31) * 8), voff = (unsigned)(vrow * 1024 + vch * 8), ooff = (unsigned)((16 * nt + l15) * 1024 + 16 * mtb + 4 * g4);
    auto gload = [&](int ch) {
        const unsigned c0 = (unsigned)ch * 65536u;
#pragma unroll
        for (int k = 0; k < 4; ++k) { pq[k] = *(const u32x4*)(Qb + (c0 + qoff + k * 16384u)); pk[k] = *(const u32x4*)(Kb + (c0 + qoff + k * 16384u)); }
        pv = *(const u32x4*)(Vb + (c0 + voff));
    };
    auto gload_rg = [&](int ch) {
#pragma unroll
        for (int mi = 0; mi < 2; ++mi) rgc[mi] = *(const u32x2*)(Rb + ((unsigned)ch * 65536u + ooff + 16 * mi));
    };
    gload(0); gload_rg(0);
    f32x4 accSt[4][2];
    float* sout = p.out + (samp ? O_RSS : O_RSP) + ((size_t)(b * 4 + h) * 256) * 256 + sl * 64;
    const float* sin_ = p.crs + ((size_t)(b * 4 + h) * 256) * 256 + sl * 64;
#pragma unroll
    for (int mt4 = 0; mt4 < 4; ++mt4)
#pragma unroll
        for (int ni = 0; ni < 2; ++ni) {
            const int dk = 32 * wave + 16 * ni + l15, dv = 16 * mt4 + 4 * g4;
            accSt[mt4][ni] = samp ? *(const f32x4*)(sin_ + (size_t)dk * 256 + dv) : (f32x4){0.f, 0.f, 0.f, 0.f};
            *(LAS u32x2*)(L + R_ST + dk * VP + dv * 2) = pack4(accSt[mt4][ni]);
        }
    for (int ch = 0; ch < nch; ++ch) {
#pragma unroll
        for (int k = 0; k < 4; ++k) { const int c = tid + 512 * k, row = c >> 5, cc = c & 31; *(LAS u32x4*)(L + R_QS + row * QP + cc * 16) = pq[k]; *(LAS u32x4*)(L + R_KS + row * QP + cc * 16) = pk[k]; }
        *(LAS u32x4*)(L + R_VS + vrow * VP2 + vch * 16) = pv;
        { f32x4 a, c2; a.x = bf_lo(pv.x) * vdec; a.y = bf_hi(pv.x) * vdec; a.z = bf_lo(pv.y) * vdec; a.w = bf_hi(pv.y) * vdec; c2.x = bf_lo(pv.z) * vdec; c2.y = bf_hi(pv.z) * vdec; c2.z = bf_lo(pv.w) * vdec; c2.w = bf_hi(pv.w) * vdec;
          *(LAS bf16x8*)(L + R_VD + vrow * VP + vch * 16) = pack8(a, c2); }
        lds_barrier();
        if (ch + 1 < nch) gload(ch + 1);
        if (pmode != 2) {
        bf16x8 qf[8];
#pragma unroll
        for (int ks = 0; ks < 8; ++ks) qf[ks] = lds16(L + R_QS + (16 * nt + l15) * QP + (32 * ks + 8 * g4) * 2);
        f32x4 accS[4];
#pragma unroll
        for (int jt = 0; jt < 4; ++jt) { accS[jt] = (f32x4){0.f, 0.f, 0.f, 0.f};
#pragma unroll
            for (int ks = 0; ks < 8; ++ks) accS[jt] = mfma16(lds16(L + R_KS + (16 * jt + l15) * QP + (32 * ks + 8 * g4) * 2), qf[ks], accS[jt]); }
        const int il = 16 * nt + l15;
#pragma unroll
        for (int jt = 0; jt < 4; ++jt) { const int j0 = 16 * jt + 4 * g4;
            accS[jt].x *= ex2(fabsf((float)(il - j0)) * l2g); accS[jt].y *= ex2(fabsf((float)(il - j0 - 1)) * l2g);
            accS[jt].z *= ex2(fabsf((float)(il - j0 - 2)) * l2g); accS[jt].w *= ex2(fabsf((float)(il - j0 - 3)) * l2g); }
        bf16x8 pS[2]; pS[0] = pack8(accS[0], accS[1]); pS[1] = pack8(accS[2], accS[3]);
        const float qdec = ex2((float)(il + 1) * l2g);
        const size_t orow = (size_t)(rowb + ch * 64 + il);
        float ssq = 0.f;
#pragma unroll
        for (int mi = 0; mi < 2; ++mi) { const int mt = mtb + mi; const int cb = (16 * mt + 4 * (l15 & 3)) * 2;
            f32x4 aI = (f32x4){0.f, 0.f, 0.f, 0.f}, aC = (f32x4){0.f, 0.f, 0.f, 0.f};
#pragma unroll
            for (int kk = 0; kk < 2; ++kk) { lptr v0 = L + R_VS + (32 * kk + 4 * g4 + (l15 >> 2)) * VP2 + cb; aI = mfma16(tr_pair(v0, v0 + 16 * VP2), pS[kk], aI); }
#pragma unroll
            for (int ks = 0; ks < 8; ++ks) { lptr s0 = L + R_ST + (32 * ks + 8 * g4 + (l15 >> 2)) * VP + cb; aC = mfma16(tr_pair(s0, s0 + 4 * VP), qf[ks], aC); }
            const f32x4 o = aI + aC * qdec;
            const f32x4 og = (f32x4){o.x * bf_lo(rgc[mi].x), o.y * bf_hi(rgc[mi].x), o.z * bf_lo(rgc[mi].y), o.w * bf_hi(rgc[mi].y)};
            if (!dry || o.x == 1.2345e30f) *(u32x2*)(Vb + ((unsigned)ch * 65536u + ooff + 16 * mi)) = pack4(og);
            ssq += dot4(o); }
        if (ch + 1 < nch) gload_rg(ch + 1);
        ssq += __shfl_xor(ssq, 16); ssq += __shfl_xor(ssq, 32);
        if (g4 == 0 && (!dry || ssq == 1.2345e30f)) unsafeAtomicAdd(ssqr + orow * 4 + h, ssq);
        }
        if (pmode != 1) {
#pragma unroll
        for (int mt4 = 0; mt4 < 4; ++mt4)
#pragma unroll
            for (int ni = 0; ni < 2; ++ni) accSt[mt4][ni] = accSt[mt4][ni] * g64;
#pragma unroll
        for (int kk = 0; kk < 2; ++kk) { const int r0 = 32 * kk + 8 * g4 + (l15 >> 2);
            bf16x8 bfr[2];
#pragma unroll
            for (int ni = 0; ni < 2; ++ni) { lptr k0 = L + R_KS + r0 * QP + (32 * wave + 16 * ni + 4 * (l15 & 3)) * 2; bfr[ni] = tr_pair(k0, k0 + 4 * QP); }
#pragma unroll
            for (int mt4 = 0; mt4 < 4; ++mt4) { lptr v0 = L + R_VD + r0 * VP + (16 * mt4 + 4 * (l15 & 3)) * 2; const bf16x8 afr = tr_pair(v0, v0 + 4 * VP);
#pragma unroll
                for (int ni = 0; ni < 2; ++ni) accSt[mt4][ni] = mfma16(afr, bfr[ni], accSt[mt4][ni]); } }
        }
        lds_barrier();
#pragma unroll
        for (int mt4 = 0; mt4 < 4; ++mt4)
#pragma unroll
            for (int ni = 0; ni < 2; ++ni) *(LAS u32x2*)(L + R_ST + (32 * wave + 16 * ni + l15) * VP + (16 * mt4 + 4 * g4) * 2) = pack4(accSt[mt4][ni]);
    }
#pragma unroll
    for (int mt4 = 0; mt4 < 4; ++mt4)
#pragma unroll
        for (int ni = 0; ni < 2; ++ni) if (!dry || accSt[mt4][ni].x == 1.2345e30f) *(f32x4*)(sout + (size_t)(32 * wave + 16 * ni + l15) * 256 + 16 * mt4 + 4 * g4) = accSt[mt4][ni];
}

constexpr int S_KS = 0, S_VS = 27648;
DI void swa_build_bias(const Params& p, lptr L, int tid) {
    LAS float* bl = (LAS float*)(L + L_BIAS);
    for (int i = tid; i < 16 * 256; i += 512) { const int hq = i >> 8, idx = i & 255; const int rel = idx - 191; const int n = rel < 0 ? -rel : rel;
        int large = 2 + (31 - __builtin_clz((unsigned)(n * n) | 1u)); large = large < 15 ? large : 15;
        const int bucket = (rel > 0 ? 16 : 0) + (n < 8 ? n : large);
        bl[i] = p.relb[bucket * 16 + hq]; }
}
struct SwaU { int b, n, kvh, row0; bool samp; };
DI SwaU swa_decode(int unit) { SwaU u; u.samp = unit >= 2048; if (!u.samp) { u.b = unit >> 7; u.n = (unit >> 1) & 63; } else { u.b = (unit - 2048) >> 1; u.n = 2; } u.kvh = unit & 1;
    u.row0 = u.samp ? MP + u.b * 64 : u.b * SEQ + u.n * 64; return u; }
DI void swa_gload(const Params& p, const SwaU& u, int tid, u32x4 (&kr)[3], u32x4 (&vr)[3]) {
    const bf16_t* P = (const bf16_t*)(p.ws + WS_P);
#pragma unroll
    for (int k = 0; k < 3; ++k) { const int c = tid + 512 * k, row = c >> 3, cc = c & 7; kr[k] = (u32x4){0u, 0u, 0u, 0u}; vr[k] = kr[k];
        if (u.n * 64 - 128 + row >= 0) { const bf16_t* src = P + G_SKV + (size_t)(u.row0 - 128 + row) * 256 + u.kvh * 64 + cc * 8; kr[k] = *(const u32x4*)src; vr[k] = *(const u32x4*)(src + 128); } }
}
DI void swa_stage_sample(const Params& p, lptr L, const SwaU& u, int tid) {
    const bf16_t* P = (const bf16_t*)(p.ws + WS_P);
#pragma unroll 1
    for (int k = 0; k < 3; ++k) { const int c = tid + 512 * k, row = c >> 3, cc = c & 7; u32x4 kv, vv;
        if (row < 128) { const size_t o = ((size_t)(u.b * 128 + row) * 2 + u.kvh) * 64 + cc * 8;
            kv = __builtin_bit_cast(u32x4, pack8(*(const f32x4*)(p.csk + o), *(const f32x4*)(p.csk + o + 4))); vv = __builtin_bit_cast(u32x4, pack8(*(const f32x4*)(p.csv + o), *(const f32x4*)(p.csv + o + 4))); }
        else { const bf16_t* src = P + G_SKV + (size_t)(u.row0 - 128 + row) * 256 + u.kvh * 64 + cc * 8; kv = *(const u32x4*)src; vv = *(const u32x4*)(src + 128); }
        *(LAS u32x4*)(L + S_KS + row * VP + cc * 16) = kv; *(LAS u32x4*)(L + S_VS + row * VP2 + cc * 16) = vv; }
}
DI void swa_phase(const Params& p, lptr L, int tid, int lane, int wave, const bool dry = false) {
    bf16_t* P = (bf16_t*)(p.ws + WS_P);
    const int G = gridDim.x, NU = 2048 + 32; const int l15 = lane & 15, g4 = lane >> 4;
    int unit = blockIdx.x; if (unit >= NU) return;
    u32x4 kr[3], vr[3];
    SwaU u = swa_decode(unit);
    for (; unit < NU; unit += G) {
        u = swa_decode(unit);
        const int hq = u.kvh * 8 + wave; const float sink = p.sinks[hq];
        bf16_t* qbase = P + G_SQ + (size_t)(u.row0 + l15) * 1024 + hq * 64;
        bf16x8 qn0 = *(const bf16x8*)(qbase + 8 * g4), qn1 = *(const bf16x8*)(qbase + 32 + 8 * g4);
        lds_barrier();
        if (u.samp) swa_stage_sample(p, L, u, tid);
        else { swa_gload(p, u, tid, kr, vr);
#pragma unroll
            for (int k = 0; k < 3; ++k) { const int c = tid + 512 * k, row = c >> 3, cc = c & 7; *(LAS u32x4*)(L + S_KS + row * VP + cc * 16) = kr[k]; *(LAS u32x4*)(L + S_VS + row * VP2 + cc * 16) = vr[k]; } }
        lds_barrier();
        const LAS float* bl = (const LAS float*)(L + L_BIAS) + hq * 256;
        const int kmin = 128 - u.n * 64;
#pragma unroll 1
        for (int qb = 0; qb < 4; ++qb) {
            const int iq = qb * 16 + l15; bf16_t* qp = qbase + (size_t)qb * 16 * 1024;
            const bf16x8 q0 = qn0, q1 = qn1;
            if (qb < 3) { qn0 = *(const bf16x8*)(qp + (size_t)16 * 1024 + 8 * g4); qn1 = *(const bf16x8*)(qp + (size_t)16 * 1024 + 32 + 8 * g4); }
            f32x4 s[12]; float mx = -3.0e38f;
#pragma unroll
            for (int tg = 0; tg < 12; tg += 4) {
                bf16x8 kf[4][2]; f32x4 bb[4];
#pragma unroll
                for (int t4 = 0; t4 < 4; ++t4) { const int t = tg + t4;
                    kf[t4][0] = lds16(L + S_KS + (16 * t + l15) * VP + (8 * g4) * 2); kf[t4][1] = lds16(L + S_KS + (16 * t + l15) * VP + (32 + 8 * g4) * 2);
                    const int bi = 16 * t + 4 * g4 + 63 - iq; bb[t4] = (f32x4){bl[bi], bl[bi + 1], bl[bi + 2], bl[bi + 3]}; }
                __builtin_amdgcn_sched_barrier(0);
#pragma unroll
                for (int t4 = 0; t4 < 4; ++t4) { const int t = tg + t4;
                    s[t] = mfma16(kf[t4][0], q0, (f32x4){0.f, 0.f, 0.f, 0.f}); s[t] = mfma16(kf[t4][1], q1, s[t]); }
#pragma unroll
                for (int t4 = 0; t4 < 4; ++t4) { const int t = tg + t4; const int key = 16 * t + 4 * g4;
                    s[t] = s[t] + bb[t4];
                    if (kmin > 0) { if (key < kmin) s[t].x = -1e30f; if (key + 1 < kmin) s[t].y = -1e30f; if (key + 2 < kmin) s[t].z = -1e30f; if (key + 3 < kmin) s[t].w = -1e30f; }
                    mx = fmaxf(mx, fmaxf(fmaxf(s[t].x, s[t].y), fmaxf(s[t].z, s[t].w))); }
                __builtin_amdgcn_sched_barrier(0);
            }
            mx = fmaxf(mx, __shfl_xor(mx, 16)); mx = fmaxf(mx, __shfl_xor(mx, 32)); mx = fmaxf(mx, sink);
            float sum = 0.f; const float mb = mx * LOG2E;
#pragma unroll
            for (int t = 0; t < 12; ++t) { s[t].x = ex2(s[t].x * LOG2E - mb); s[t].y = ex2(s[t].y * LOG2E - mb); s[t].z = ex2(s[t].z * LOG2E - mb); s[t].w = ex2(s[t].w * LOG2E - mb);
                sum += (s[t].x + s[t].y) + (s[t].z + s[t].w); }
            sum += __shfl_xor(sum, 16); sum += __shfl_xor(sum, 32);
            const float inv = 1.f / (sum + ex2(sink * LOG2E - mb));
            f32x4 o[4];
#pragma unroll
            for (int mt = 0; mt < 4; ++mt) o[mt] = (f32x4){0.f, 0.f, 0.f, 0.f};
#pragma unroll
            for (int kk = 0; kk < 6; ++kk) { const bf16x8 pf = pack8(s[2 * kk] * inv, s[2 * kk + 1] * inv);
#pragma unroll
                for (int mt = 0; mt < 4; ++mt) { lptr v0 = L + S_VS + (32 * kk + 4 * g4 + (l15 >> 2)) * VP2 + (16 * mt + 4 * (l15 & 3)) * 2; o[mt] = mfma16(tr_pair(v0, v0 + 16 * VP2), pf, o[mt]); }
                if (kk & 1) __builtin_amdgcn_sched_barrier(0); }
#pragma unroll
            for (int mt = 0; mt < 4; ++mt) if (!dry || o[mt].x == 1.2345e30f) *(u32x2*)(qp + 16 * mt + 4 * g4) = pack4(o[mt]);
        }
    }
    __syncthreads();
}

DI int cross_unit_of(int item, int c, int G) { if (G != 256) return item * G + c; if (item < 8) return ((8 * item + (c & 7)) << 5) + (c >> 3); return (item == 8 && c < 64) ? 2048 + c : -1; }
struct CrU { int b, hh, row0, nq; const bf16_t* Kg; const bf16_t* Vg; };
DI CrU cross_decode(const Params& p, int unit) { CrU u; const bool samp = unit >= 2048;
    if (!samp) { u.b = unit >> 7; u.hh = (unit >> 5) & 3; u.row0 = u.b * SEQ + (unit & 31) * 128; u.nq = 128; } else { const int u2 = unit - 2048; u.b = u2 >> 2; u.hh = u2 & 3; u.row0 = MP + u.b * 64; u.nq = 64; }
    u.Kg = (const bf16_t*)(p.ws + (samp ? WS_CKVB : WS_MKVB)) + (size_t)u.b * 256 * 2048 + u.hh * 256; u.Vg = u.Kg + 1024; return u; }
constexpr int CR_BUF = 34816;
DI const bf16_t* cross_blk(const CrU& u, int j) { return (j < 4 ? u.Kg : u.Vg) + (size_t)((j & 3) * 64) * 2048; }
DI void cross_gload(const bf16_t* src, int tid, u32x4 (&r)[4]) {
#pragma unroll
    for (int k = 0; k < 4; ++k) { const int c = tid + 512 * k, row = c >> 5, cc = c & 31; r[k] = *(const u32x4*)(src + (size_t)row * 2048 + cc * 8); }
}
DI void cross_swrite(lptr B, int tid, const u32x4 (&r)[4], const int pitch) {
#pragma unroll
    for (int k = 0; k < 4; ++k) { const int c = tid + 512 * k, row = c >> 5, cc = c & 31; *(LAS u32x4*)(B + row * pitch + cc * 16) = r[k]; }
}
DI void cross_phase(const Params& p, lptr L, int tid, int lane, int wave, const bool dry = false, const int pmode = 0) {
    bf16_t* P = (bf16_t*)(p.ws + WS_P);
    const int G = gridDim.x, NU = 2048 + 64, cbk = blockIdx.x; const int l15 = lane & 15, g4 = lane >> 4;
    int item = 0, unit = cross_unit_of(0, cbk, G); if (unit < 0 || unit >= NU) return;
    u32x4 pre[4];
    CrU u = cross_decode(p, unit);
    cross_gload(cross_blk(u, 0), tid, pre); cross_swrite(L, tid, pre, QP);
    cross_gload(cross_blk(u, 1), tid, pre);
    for (;;) {
        const int unext = cross_unit_of(item + 1, cbk, G); const bool has_next = unext >= 0 && unext < NU;
        CrU un = u; if (has_next) un = cross_decode(p, unext);
        const bool active = wave * 16 < u.nq && pmode != 1;
        bf16_t* qp = P + G_RK + (size_t)(u.row0 + (wave * 16 < u.nq ? wave * 16 + l15 : 0)) * 1024 + u.hh * 256;
        bf16x8 qf[8];
#pragma unroll
        for (int ks = 0; ks < 8; ++ks) qf[ks] = *(const bf16x8*)(qp + 32 * ks + 8 * g4);
        f32x4 s[16];
#pragma unroll
        for (int t = 0; t < 16; ++t) s[t] = (f32x4){0.f, 0.f, 0.f, 0.f};
        bf16x8 pf[8];
        f32x4 o[16];
#pragma unroll
        for (int i = 0; i < 8; ++i) {
            lds_barrier();
            lptr cur = L + (i & 1) * CR_BUF, oth = L + ((i + 1) & 1) * CR_BUF;
            if (pmode != 2) {
                if (i < 7 || has_next) cross_swrite(oth, tid, pre, (i + 1) & 4 ? QP2 : QP);
                if (i < 6) cross_gload(cross_blk(u, i + 2), tid, pre); else if (has_next) cross_gload(cross_blk(un, i - 6), tid, pre);
            }
            if (i < 4) {
                if (active) {
#pragma unroll
                    for (int t = 0; t < 4; ++t)
#pragma unroll
                        for (int ks = 0; ks < 8; ++ks) s[i * 4 + t] = mfma16(lds16(cur + (16 * t + l15) * QP + (32 * ks + 8 * g4) * 2), qf[ks], s[i * 4 + t]);
                }
                if (i == 3) {
                    float mx = -3.0e38f;
#pragma unroll
                    for (int t = 0; t < 16; ++t) mx = fmaxf(mx, fmaxf(fmaxf(s[t].x, s[t].y), fmaxf(s[t].z, s[t].w)));
                    mx = fmaxf(mx, __shfl_xor(mx, 16)); mx = fmaxf(mx, __shfl_xor(mx, 32));
                    float sum = 0.f; const float mb = mx * LOG2E;
#pragma unroll
                    for (int t = 0; t < 16; ++t) { s[t].x = ex2(s[t].x * LOG2E - mb); s[t].y = ex2(s[t].y * LOG2E - mb); s[t].z = ex2(s[t].z * LOG2E - mb); s[t].w = ex2(s[t].w * LOG2E - mb);
                        sum += (s[t].x + s[t].y) + (s[t].z + s[t].w); }
                    sum += __shfl_xor(sum, 16); sum += __shfl_xor(sum, 32);
                    const float inv = 1.f / sum;
#pragma unroll
                    for (int kk = 0; kk < 8; ++kk) pf[kk] = pack8(s[2 * kk] * inv, s[2 * kk + 1] * inv);
#pragma unroll
                    for (int mt = 0; mt < 16; ++mt) o[mt] = (f32x4){0.f, 0.f, 0.f, 0.f};
                }
            } else {
                const int vb = i - 4;
                if (active) {
#pragma unroll
                    for (int k2 = 0; k2 < 2; ++k2)
#pragma unroll
                        for (int mt = 0; mt < 16; ++mt) { lptr v0 = cur + (32 * k2 + 4 * g4 + (l15 >> 2)) * QP2 + (16 * mt + 4 * (l15 & 3)) * 2; o[mt] = mfma16(tr_pair(v0, v0 + 16 * QP2), pf[2 * vb + k2], o[mt]); }
                }
            }
        }
        if (active) {
#pragma unroll
            for (int mt = 0; mt < 16; ++mt) if (!dry || o[mt].x == 1.2345e30f) *(u32x2*)(qp + 16 * mt + 4 * g4) = pack4(o[mt]);
        }
        if (!has_next) break;
        unit = unext; ++item; u = un;
    }
    __syncthreads();
}
DI void pass_final(const Params& p, int lane, int wave, const int row_lo) {
    const float* ssq = (const float*)(p.ws + WS_SSQ4);
    const int gw = blockIdx.x * 8 + wave, NGW = gridDim.x * 8;
    f32x4 g[4];
#pragma unroll
    for (int j = 0; j < 4; ++j) g[j] = *((const f32x4*)p.g_final + lane + 64 * j);
    for (int m = row_lo + gw; m < MT; m += NGW) { const float rs = 1.f / sqrtf(ssq[m] * (1.f / DM) + EPS); f32x4* h = (f32x4*)(p.out + (size_t)m * DM) + lane;
#pragma unroll
        for (int j = 0; j < 4; ++j) h[64 * j] = h[64 * j] * g[j] * rs; }
}
DI void pass_swa_cache_out(const Params& p, int tid) {
    const bf16_t* P = (const bf16_t*)(p.ws + WS_P);
    const int gt = blockIdx.x * 512 + tid, GT = gridDim.x * 512;
    for (int i = gt; i < 4 * 262144; i += GT) { const int which = i >> 18, r = i & 262143, b = r >> 14, j = (r >> 7) & 127, c = r & 127;
        const bool isv = which >= 2, samp = which & 1; float v;
        if (!samp) v = bf_lo((unsigned)P[G_SKV + (size_t)(b * SEQ + SEQ - 128 + j) * 256 + (isv ? 128 : 0) + c]);
        else if (j < 64) v = (isv ? p.csv : p.csk)[(size_t)(b * 128 + 64 + j) * 128 + c];
        else v = bf_lo((unsigned)P[G_SKV + (size_t)(MP + b * 64 + j - 64) * 256 + (isv ? 128 : 0) + c]);
        p.out[(which == 0 ? O_KP : which == 1 ? O_KS : which == 2 ? O_VP : O_VS) + r] = v; }
}


#define XB_TMO      128
#define XB_XCNT(j)  (256  + 64 * (j))
#define XB_XSUB(j)  (1280 + 64 * (j))
#define XB_XGEN(j)  (2304 + 64 * (j))
#define XB_TOP      3328
#define XB_TOPGEN   3392
#define XCD_BAR_WORDS 3456
#define XB_SPIN_CAP (1u << 18)
constexpr size_t WS_BAR = 1900544;
static_assert(WS_BAR >= WS_ZEND && WS_BAR + XCD_BAR_WORDS * 4 <= WS_WIN && WS_BAR % 256 == 0, "barrier words");
constexpr int L_MISC = 141312;
DI unsigned xb_ld(unsigned* p)              { return __hip_atomic_load(p, __ATOMIC_RELAXED, __HIP_MEMORY_SCOPE_AGENT); }
DI unsigned xb_add(unsigned* p, unsigned v) { return __hip_atomic_fetch_add(p, v, __ATOMIC_RELAXED, __HIP_MEMORY_SCOPE_AGENT); }
DI unsigned xb_xcc_id() { return (unsigned)__builtin_amdgcn_s_getreg((3 << 11) | 20) & 0xFu; }
#define XB_SPIN(cond, bar) do { unsigned _sp = 0; while (cond) { __builtin_amdgcn_s_sleep(1); \
    if ((++_sp & 255u) == 0u) { if (xb_ld(&(bar)[XB_TMO])) break; if (_sp > XB_SPIN_CAP) { atomicAdd(&(bar)[XB_TMO], 1u); break; } } } } while (0)
struct XcdBarrier { unsigned* bar; unsigned x; volatile LAS unsigned* st; };
DI XcdBarrier xcd_barrier_post(unsigned* bar, volatile LAS unsigned* st) {
    XcdBarrier b; b.bar = bar; b.x = xb_xcc_id(); b.st = st;
    if (threadIdx.x == 0) (void)xb_add(&bar[XB_XCNT(b.x)], 1u);
    return b;
}
DI void xcd_barrier_complete(unsigned* bar, unsigned x, unsigned& nloc, unsigned& nx) {
    const unsigned G = gridDim.x * gridDim.y * gridDim.z;
    unsigned sum, cnt, mine, sp = 0u;
    for (;;) {
        sum = 0u; cnt = 0u; mine = 0u;
#pragma unroll
        for (unsigned j = 0; j < 16; ++j) { const unsigned c = xb_ld(&bar[XB_XCNT(j)]); sum += c; cnt += (c > 0u) ? 1u : 0u; mine = (j == x) ? c : mine; }
        if (sum == G) break;
        __builtin_amdgcn_s_sleep(1);
        if ((++sp & 255u) == 0u) { if (xb_ld(&bar[XB_TMO])) break; if (sp > XB_SPIN_CAP) { atomicAdd(&bar[XB_TMO], 1u); break; } }
    }
    nloc = mine > 0u ? mine : 1u; nx = cnt > 0u ? cnt : 1u;
}
DI void xcd_barrier(const XcdBarrier& b) {
    asm volatile("s_waitcnt vmcnt(0)" ::: "memory");
    __syncthreads();
    if (threadIdx.x == 0) {
        unsigned* bar = b.bar;
        __builtin_amdgcn_s_waitcnt(0);
        unsigned nloc = b.st[0], nx = b.st[1];
        if (nloc == 0u) { xcd_barrier_complete(bar, b.x, nloc, nx); b.st[0] = nloc; b.st[1] = nx; }
        const unsigned old = xb_add(&bar[XB_XSUB(b.x)], 1u);
        const unsigned gen = old / nloc;
        if (old + 1u == (gen + 1u) * nloc) {
            __builtin_amdgcn_fence(__ATOMIC_RELEASE, "agent");
            asm volatile("s_waitcnt vmcnt(0)" ::: "memory");
            const unsigned og = xb_add(&bar[XB_TOP], 1u);
            const unsigned tg = og / nx;
            if (og + 1u == (tg + 1u) * nx) xb_add(&bar[XB_TOPGEN], 1u);
            else XB_SPIN(xb_ld(&bar[XB_TOPGEN]) == tg, bar);
            __builtin_amdgcn_fence(__ATOMIC_ACQUIRE, "agent");
            xb_add(&bar[XB_XGEN(b.x)], 1u);
            asm volatile("s_waitcnt vmcnt(0)" ::: "memory");
        } else {
            XB_SPIN(xb_ld(&bar[XB_XGEN(b.x)]) == gen, bar);
            __builtin_amdgcn_fence(__ATOMIC_ACQUIRE, "agent");
            asm volatile("s_waitcnt vmcnt(0)" ::: "memory");
        }
    }
    __syncthreads();
}

constexpr int N_PHASES = 12;
#ifndef PROBE_PHASE
#define PROBE_PHASE 0
#endif
__global__ void __launch_bounds__(512, 2) fwd_mega(Params p) {
    extern __shared__ __attribute__((aligned(16))) unsigned char lds_raw[];
    lptr L = (lptr)lds_raw;
    const int tid = threadIdx.x, lane = tid & 63, wave = __builtin_amdgcn_readfirstlane(tid >> 6);
    const int G = gridDim.x, cb = blockIdx.x;
    unsigned char* ws = p.ws; bf16_t* P = (bf16_t*)(ws + WS_P);
    const int lo = p.ph_lo, hi = p.ph_hi;
#define IN(k) (lo <= (k) && (k) < hi)
    if (tid < 2) ((volatile LAS unsigned*)(L + L_MISC))[tid] = 0u;
    __syncthreads();
    const XcdBarrier xbar = xcd_barrier_post((unsigned*)(ws + WS_BAR), (volatile LAS unsigned*)(L + L_MISC));
#define SEAM(k) do { if (IN(k) && IN((k) + 1)) xcd_barrier(xbar); } while (0)
    if (lo < 0) cg::this_grid().sync();
#if PROBE_PHASE == 5
    for (int i = 0; i < 10; ++i) cg::this_grid().sync();
#endif
#if PROBE_PHASE == 6
    phase_prep(p, L, tid, lane, wave);
#endif
    if (IN(0)) { phase_prep(p, L, tid, lane, wave); }
    SEAM(0);
    if (IN(1)) {
#if PROBE_PHASE == 4
        { pg8::Gemm g{(const bf16_t*)((unsigned char*)p.out + OB_XB), DM, (const bf16_t*)(ws + WS_WIN), MT, DIN, DM}; pg8::StaticOrder S; S.init(MT, DIN, G, cb);
          EpiInProj E{P, p.out + O_RSTD1, (const unsigned*)(p.out + O_ROPE)}; pg8::gemm_phase<EpiInProj, true>(L, g, S, E); }
#endif
        { pg8::Gemm g{(const bf16_t*)((unsigned char*)p.out + OB_XB), DM, (const bf16_t*)(ws + WS_WIN), MT, DIN, DM}; pg8::StaticOrder S; S.init(MT, DIN, G, cb);
          EpiInProj E{P, p.out + O_RSTD1, (const unsigned*)(p.out + O_ROPE)}; pg8::gemm_phase<EpiInProj, true>(L, g, S, E); }
        { const int r = ((MT / 256) * (DIN / 256)) % G; const int c2 = (cb - r + G) % G;
          pg8::Gemm g{(const bf16_t*)((unsigned char*)p.out + OB_MB), DM, (const bf16_t*)(ws + WS_WMKV), NB * NMEM, 2048, DM}; pg8::StaticOrder S; S.init(NB * NMEM, 2048, G, c2);
          EpiMemKV E{p.out + O_MK, p.out + O_MV, p.out + O_RSTDM, (bf16_t*)(ws + WS_MKVB)}; pg8::gemm_phase<EpiMemKV, true>(L, g, S, E); }
    }
    SEAM(1);
    if (IN(2)) {
        swa_build_bias(p, L, tid);
        pass_swa_cache_out(p, tid);
#if PROBE_PHASE == 1
        for (int s = cb; s < 512; s += G) retention_stream(p, L, s, tid, lane, wave, true);
        __syncthreads();
#endif
#if PROBE_PHASE == 10
        for (int s = cb; s < 512; s += G) retention_stream(p, L, s, tid, lane, wave, true, 1);
        __syncthreads();
#endif
#if PROBE_PHASE == 11
        for (int s = cb; s < 512; s += G) retention_stream(p, L, s, tid, lane, wave, true, 2);
        __syncthreads();
#endif
#if PROBE_PHASE == 2
        swa_phase(p, L, tid, lane, wave, true);
#endif
        for (int s = cb; s < 512; s += G) { int st = s; if (G == 256) { const int c = s & 255; st = (s & 256) | ((((c & 7) + 8 * (c >> 5)) << 2) | ((c >> 3) & 3)); }
            retention_stream(p, L, st, tid, lane, wave); }
        __syncthreads();
        swa_phase(p, L, tid, lane, wave);
    }
    SEAM(2);
    if (IN(3)) {
        pg8::Gemm g{P + G_SQ, DM, (const bf16_t*)(ws + WS_WSO), MP, DM, DM}; pg8::StaticOrder S; S.init(MP, DM, G, cb);
        EpiSwaOut E{P}; pg8::gemm_phase<EpiSwaOut, true>(L, g, S, E);
        pg8::Gemm gs{P + G_SQ + (size_t)MP * DM, DM, (const bf16_t*)(ws + WS_WSO), MS, DM, DM}; mini_gemm_phase<EpiSwaOut>(L, gs, MP, E);
        {
        pg8::Gemm g{P + G_RV, DM, (const bf16_t*)(ws + WS_WRO), MP, DM, DM}; pg8::StaticOrder S; S.init(MP, DM, G, cb);
        EpiRetOut E{P, (const float*)(ws + WS_SSQR), L + 131072}; pg8::gemm_phase<EpiRetOut, true>(L, g, S, E);
        pg8::Gemm gs{P + G_RV + (size_t)MP * DM, DM, (const bf16_t*)(ws + WS_WRO), MS, DM, DM}; mini_gemm_phase<EpiRetOut>(L, gs, MP, E);
        }
    }
    SEAM(3);
    if (IN(5)) {
        pg8::Gemm g{P + G_GA, DM, (const bf16_t*)(ws + WS_WMX), MP, DM, DM}; pg8::StaticOrder S; S.init(MP, DM, G, cb);
        EpiResid<true, true> E{p.xp, p.xs, p.out, P, (float*)(ws + WS_SSQ2)}; pg8::gemm_phase<EpiResid<true, true>, true>(L, g, S, E);
        pg8::Gemm gs{P + G_GA + (size_t)MP * DM, DM, (const bf16_t*)(ws + WS_WMX), MS, DM, DM}; mini_gemm_phase<EpiResid<true, true>>(L, gs, MP, E);
    }
    SEAM(5);
    if (IN(6)) {
#if PROBE_PHASE == 9
        { pg8::Gemm g{P + G_RQ, DM, (const bf16_t*)(ws + WS_WCQ), MP, DM, DM}; pg8::StaticOrder S; S.init(MP, DM, G, cb);
          EpiCq E{P, (const float*)(ws + WS_SSQ2)}; pg8::gemm_phase<EpiCq, true>(L, g, S, E); }
#endif
        pg8::Gemm g{P + G_RQ, DM, (const bf16_t*)(ws + WS_WCQ), MP, DM, DM}; pg8::StaticOrder S; S.init(MP, DM, G, cb);
        EpiCq E{P, (const float*)(ws + WS_SSQ2)}; pg8::gemm_phase<EpiCq, true>(L, g, S, E);
        pg8::Gemm gs{P + G_RQ + (size_t)MP * DM, DM, (const bf16_t*)(ws + WS_WCQ), MS, DM, DM}; mini_gemm_phase<EpiCq>(L, gs, MP, E);
    }
    SEAM(6);
    if (IN(7)) {
#if PROBE_PHASE == 3
        cross_phase(p, L, tid, lane, wave, true);
#endif
#if PROBE_PHASE == 7
        cross_phase(p, L, tid, lane, wave, true, 1);
#endif
#if PROBE_PHASE == 8
        cross_phase(p, L, tid, lane, wave, true, 2);
#endif
        cross_phase(p, L, tid, lane, wave); }
    SEAM(7);
    if (IN(8)) {
        pg8::Gemm g{P + G_RK, DM, (const bf16_t*)(ws + WS_WCO), MP, DM, DM}; pg8::StaticOrder S; S.init(MP, DM, G, cb);
        EpiResid<false, true> E{p.xp, p.xs, p.out, P, (float*)(ws + WS_SSQ3)}; pg8::gemm_phase<EpiResid<false, true>, true>(L, g, S, E);
        pg8::Gemm gs{P + G_RK + (size_t)MP * DM, DM, (const bf16_t*)(ws + WS_WCO), MS, DM, DM}; mini_gemm_phase<EpiResid<false, true>>(L, gs, MP, E);
    }
    SEAM(8);
    if (IN(9)) {
        pg8::Gemm g{P + G_RQ, DM, (const bf16_t*)(ws + WS_WGU), MP, 2 * DFF, DM}; pg8::StaticOrder S; S.init(MP, 2 * DFF, G, cb);
        EpiGateUp E{P, (const float*)(ws + WS_SSQ3)}; pg8::gemm_phase<EpiGateUp, true>(L, g, S, E);
        pg8::Gemm gs{P + G_RQ + (size_t)MP * DM, DM, (const bf16_t*)(ws + WS_WGU), MS, 2 * DFF, DM}; mini_gemm_phase<EpiGateUp>(L, gs, MP, E);
    }
    SEAM(9);
    if (IN(10)) {
        pg8::Gemm g{P + G_RV, DFF, (const bf16_t*)(ws + WS_WDN), MP, DM, DFF}; pg8::StaticOrder S; S.init(MP, DM, G, cb);
        EpiResid<false, false> E{p.xp, p.xs, p.out, P, (float*)(ws + WS_SSQ4)};
        if (G == 256) { EpiDownFinal EF{p.out, p.g_final, (float*)(ws + WS_XBUF), (unsigned*)(ws + WS_XCNT), L + 131072}; pg8::gemm_phase<EpiDownFinal, true>(L, g, S, EF); }
        else pg8::gemm_phase<EpiResid<false, false>, true>(L, g, S, E);
        pg8::Gemm gs{P + G_RV + (size_t)MP * DFF, DFF, (const bf16_t*)(ws + WS_WDN), MS, DM, DFF}; mini_gemm_phase<EpiResid<false, false>>(L, gs, MP, E);
    }
    SEAM(10);
    if (IN(11)) pass_final(p, lane, wave, G == 256 ? MP : 0);
#undef IN
#undef SEAM
}

#ifndef MK_SPLIT
#define MK_SPLIT 0
#endif
extern "C" void kernel_launch(void* const* d_in, const int* in_sizes, int n_in, void* d_out, int out_size, void* d_ws, size_t ws_size, hipStream_t stream) {
    static int grid = 0;
    if (grid == 0) {
        if (n_in != 26 || ws_size < WS_END3) { fprintf(stderr, "kernel_launch: unexpected problem (n_in %d, ws %zu < %zu)\n", n_in, ws_size, (size_t)WS_END); grid = -1; return; }
        int dev = 0, cus = 0, per_cu = 0;
        hipGetDevice(&dev); hipDeviceGetAttribute(&cus, hipDeviceAttributeMultiprocessorCount, dev);
        hipFuncSetAttribute((const void*)fwd_mega, hipFuncAttributeMaxDynamicSharedMemorySize, LDS_BYTES);
        hipOccupancyMaxActiveBlocksPerMultiprocessor(&per_cu, (const void*)fwd_mega, 512, LDS_BYTES);
        (void)hipGetLastError();
        if (per_cu < 1) per_cu = 1;
        grid = cus * 1;
        if (grid <= 0) grid = 256;
    }
    if (grid < 0) return;
    (void)hipMemsetAsync((unsigned char*)d_ws + WS_BAR, 0, XCD_BAR_WORDS * 4, stream);
    Params p{};
    const float** f = (const float**)&p;
    for (int i = 0; i < 26; ++i) f[i] = (const float*)d_in[i];
    p.out = (float*)d_out; p.ws = (unsigned char*)d_ws;
#if MK_SPLIT
    for (int k = 0; k < N_PHASES; ++k) { p.ph_lo = k; p.ph_hi = k + 1; hipLaunchKernelGGL(fwd_mega, dim3(grid), dim3(512), LDS_BYTES, stream, p); }
#else
    p.ph_lo = 0; p.ph_hi = N_PHASES;
    void* args[] = {&p};
    hipError_t e = hipLaunchCooperativeKernel((const void*)fwd_mega, dim3(grid), dim3(512), args, LDS_BYTES, stream);
    if (e != hipSuccess) fprintf(stderr, "cooperative launch failed: %s (grid %d)\n", hipGetErrorString(e), grid);
#endif
}
```
